# Optimizing an MI355X kernel written in HIP

```python
import math
import jax, jax.numpy as jnp
from jax import lax
import numpy as np

D_MODEL = 1024
BATCH = 2
SEQ = 8192
DEPTH = 4

GRID_W = 64
CTX_LEN = 256

ATTN_HEADS = 4
ATTN_HEAD_DIM = 64
ATTN_V_DIM = 2 * ATTN_HEAD_DIM
ATTN_WIDTH = ATTN_HEADS * ATTN_V_DIM
QK_WIDTH = ATTN_HEADS * 2 * ATTN_HEAD_DIM
POOL_WINDOWS = (2, 4, 8, 16)
POOL_WIDTH = D_MODEL // 4
POOL_GROUP = POOL_WIDTH // len(POOL_WINDOWS)
CONV_WIDTH = D_MODEL // 4
CONV_KERNEL = 31
CONV_PAD = CONV_KERNEL // 2

MIX_WIDTH = ATTN_WIDTH + POOL_WIDTH + CONV_WIDTH
IN_WIDTH = 2 * QK_WIDTH + ATTN_WIDTH + POOL_WIDTH + 2 * CONV_WIDTH
SPLITS = (QK_WIDTH, 2 * QK_WIDTH, 2 * QK_WIDTH + ATTN_WIDTH,
          2 * QK_WIDTH + ATTN_WIDTH + POOL_WIDTH,
          2 * QK_WIDTH + ATTN_WIDTH + POOL_WIDTH + CONV_WIDTH)

FFN_HIDDEN = ((8 * D_MODEL + 3 * 256 - 1) // (3 * 256)) * 256
ROPE_THETA = 10000.0
EPS = 1e-6
BLOCK_Q = 128

kernel_name = "hybrid_diffattn_pool_conformer_dit"


def rms_norm(x, g):
    xf = x.astype(jnp.float32)
    y = xf * lax.rsqrt(jnp.mean(xf * xf, axis=-1, keepdims=True) + EPS)
    return (y * g.astype(jnp.float32)).astype(x.dtype)


def layer_norm(x, g, b):
    xf = x.astype(jnp.float32)
    mu = jnp.mean(xf, axis=-1, keepdims=True)
    var = jnp.mean(jnp.square(xf - mu), axis=-1, keepdims=True)
    y = (xf - mu) * lax.rsqrt(var + EPS)
    return (y * g.astype(jnp.float32) + b.astype(jnp.float32)).astype(x.dtype)


def adaln(cond, w_mod, b_mod):
    m = jnp.dot(jax.nn.silu(cond), w_mod) + b_mod
    return jnp.split(m[..., None, :], 6, axis=-1)


def modulate(h, shift, scale):
    return h * (1.0 + scale) + shift


def axial_rope_tables(n_rows):
    row = jnp.repeat(jnp.arange(n_rows), GRID_W).astype(jnp.float32)
    col = jnp.tile(jnp.arange(GRID_W), n_rows).astype(jnp.float32)
    half = ATTN_HEAD_DIM // 2
    inv_freq = ROPE_THETA ** (-jnp.arange(0, half, 2, dtype=jnp.float32) / half)
    ang = jnp.concatenate([row[:, None] * inv_freq, col[:, None] * inv_freq], axis=-1)
    return jnp.cos(ang), jnp.sin(ang)


def apply_rope(x, cos, sin):
    x1 = x[..., 0::2].astype(jnp.float32)
    x2 = x[..., 1::2].astype(jnp.float32)
    y1 = x1 * cos - x2 * sin
    y2 = x1 * sin + x2 * cos
    return jnp.stack([y1, y2], axis=-1).reshape(x.shape).astype(x.dtype)


def project_inputs(h, w_in, q_g, k_g):
    B, L, _ = h.shape
    proj = jnp.einsum('bld,de->ble', h, w_in)
    q, k, v, u_pool, a_conv, b_conv = jnp.split(proj, list(SPLITS), axis=-1)
    q = rms_norm(q.reshape(B, L, ATTN_HEADS, 2, ATTN_HEAD_DIM), q_g).transpose(0, 2, 3, 1, 4)
    k = rms_norm(k.reshape(B, L, ATTN_HEADS, 2, ATTN_HEAD_DIM), k_g).transpose(0, 2, 3, 1, 4)
    v = v.reshape(B, L, ATTN_HEADS, ATTN_V_DIM).transpose(0, 2, 1, 3)
    return q, k, v, u_pool, a_conv, b_conv


def diff_attention(q, k_all, v_all, lam):
    B, H, _, Lq, dh = q.shape
    nb = Lq // BLOCK_Q
    qb = q.reshape(B, H, 2, nb, BLOCK_Q, dh).transpose(3, 0, 1, 2, 4, 5)
    scale = dh ** -0.5

    def one_block(q_blk):
        s = jnp.einsum('bhcqd,bhckd->bhcqk', q_blk, k_all).astype(jnp.float32) * scale
        p = jax.nn.softmax(s, axis=-1)
        a = p[:, :, 0] - lam * p[:, :, 1]
        return jnp.einsum('bhqk,bhkd->bhqd', a.astype(v_all.dtype), v_all)

    o = lax.map(one_block, qb)
    return o.transpose(1, 2, 0, 3, 4).reshape(B, H, Lq, v_all.shape[-1])


def diff_attn_post(o, subln_g, lambda_init):
    B, H, L, dv = o.shape
    o = rms_norm(o, subln_g) * (1.0 - lambda_init)
    return o.transpose(0, 2, 1, 3).reshape(B, L, H * dv)


def multiscale_pool(u):
    B, L, C = u.shape
    uf = u.astype(jnp.float32)
    csum = jnp.concatenate([jnp.zeros((B, 1, C), jnp.float32), jnp.cumsum(uf, axis=1)], axis=1)
    t = jnp.arange(L)
    outs = []
    for gi, w in enumerate(POOL_WINDOWS):
        lo = jnp.clip(t - w // 2, 0, L)
        hi = jnp.clip(t + w - w // 2, 0, L)
        sl = slice(gi * POOL_GROUP, (gi + 1) * POOL_GROUP)
        seg = csum[:, :, sl]
        cnt = (hi - lo).astype(jnp.float32)[None, :, None]
        outs.append((seg[:, hi] - seg[:, lo]) / cnt - uf[:, :, sl])
    return jnp.concatenate(outs, axis=-1).astype(u.dtype)


def pool_mixer(u, pool_w, pool_scale):
    B, L, _ = u.shape
    p = multiscale_pool(u).reshape(B, L, len(POOL_WINDOWS), POOL_GROUP)
    y = jnp.einsum('blgc,gce->blge', p, pool_w).reshape(B, L, POOL_WIDTH)
    return y * pool_scale


def conformer_conv(a, b, dw_w, dw_b, ln_g, ln_b):
    u = a * jax.nn.sigmoid(b)
    y = lax.conv_general_dilated(
        u, dw_w[:, None, :].astype(u.dtype), window_strides=(1,),
        padding=((CONV_PAD, CONV_PAD),), dimension_numbers=('NWC', 'WIO', 'NWC'),
        feature_group_count=CONV_WIDTH)
    y = layer_norm(y + dw_b, ln_g, ln_b)
    return jax.nn.silu(y)


def swiglu(h, w_in, w_out):
    gu = jnp.einsum('bld,de->ble', h, w_in)
    g, u = jnp.split(gu, 2, axis=-1)
    return jnp.einsum('blf,fd->bld', jax.nn.silu(g) * u, w_out)


def setup_inputs(seed: int = 0) -> dict:
    key = jax.random.key(seed)
    ks = jax.random.split(key, 26)
    f32 = jnp.float32
    n = lambda k, s: jax.random.normal(k, s, f32)
    return {
        "x": n(ks[0], (BATCH, SEQ, D_MODEL)),
        "c": n(ks[1], (BATCH, D_MODEL)),
        "ctx": n(ks[2], (BATCH, CTX_LEN, D_MODEL)),
        "c_ctx": n(ks[3], (D_MODEL,)),
        "w_mod": n(ks[4], (DEPTH, D_MODEL, 6 * D_MODEL)) * (0.5 * D_MODEL ** -0.5),
        "b_mod": n(ks[5], (DEPTH, 6 * D_MODEL)) * 0.01,
        "norm1_g": 1.0 + 0.02 * n(ks[6], (DEPTH, D_MODEL)),
        "w_in": n(ks[7], (DEPTH, D_MODEL, IN_WIDTH)) * D_MODEL ** -0.5,
        "q_norm_g": 1.0 + 0.02 * n(ks[8], (DEPTH, ATTN_HEAD_DIM)),
        "k_norm_g": 1.0 + 0.02 * n(ks[9], (DEPTH, ATTN_HEAD_DIM)),
        "lambda_q1": 0.1 * n(ks[10], (DEPTH, ATTN_HEAD_DIM)),
        "lambda_k1": 0.1 * n(ks[11], (DEPTH, ATTN_HEAD_DIM)),
        "lambda_q2": 0.1 * n(ks[12], (DEPTH, ATTN_HEAD_DIM)),
        "lambda_k2": 0.1 * n(ks[13], (DEPTH, ATTN_HEAD_DIM)),
        "subln_g": 1.0 + 0.02 * n(ks[14], (DEPTH, ATTN_V_DIM)),
        "pool_w": n(ks[15], (DEPTH, len(POOL_WINDOWS), POOL_GROUP, POOL_GROUP)) * POOL_GROUP ** -0.5,
        "pool_scale": 1.0 + 0.02 * n(ks[16], (DEPTH, POOL_WIDTH)),
        "conv_dw_w": n(ks[17], (DEPTH, CONV_KERNEL, CONV_WIDTH)) * CONV_KERNEL ** -0.5,
        "conv_dw_b": 0.01 * n(ks[18], (DEPTH, CONV_WIDTH)),
        "conv_ln_g": 1.0 + 0.02 * n(ks[19], (DEPTH, CONV_WIDTH)),
        "conv_ln_b": 0.01 * n(ks[20], (DEPTH, CONV_WIDTH)),
        "w_out": n(ks[21], (DEPTH, MIX_WIDTH, D_MODEL)) * MIX_WIDTH ** -0.5,
        "norm2_g": 1.0 + 0.02 * n(ks[22], (DEPTH, D_MODEL)),
        "w_ffn_in": n(ks[23], (DEPTH, D_MODEL, 2 * FFN_HIDDEN)) * D_MODEL ** -0.5,
        "w_ffn_out": n(ks[24], (DEPTH, FFN_HIDDEN, D_MODEL)) * FFN_HIDDEN ** -0.5,
    }


def reference(x, c, ctx, c_ctx, w_mod, b_mod, norm1_g, w_in, q_norm_g, k_norm_g,
              lambda_q1, lambda_k1, lambda_q2, lambda_k2, subln_g, pool_w, pool_scale,
              conv_dw_w, conv_dw_b, conv_ln_g, conv_ln_b, w_out, norm2_g, w_ffn_in,
              w_ffn_out):
    B, L, _ = x.shape
    rows = L // GRID_W
    cos, sin = axial_rope_tables(rows)
    xc = ctx
    for l in range(DEPTH):
        last = l == DEPTH - 1
        lambda_init = 0.8 - 0.6 * math.exp(-0.3 * l)
        lam = (jnp.exp(jnp.sum(lambda_q1[l] * lambda_k1[l]).astype(jnp.float32))
               - jnp.exp(jnp.sum(lambda_q2[l] * lambda_k2[l]).astype(jnp.float32))
               + lambda_init)
        sh1, sc1, g1, sh2, sc2, g2 = adaln(c, w_mod[l], b_mod[l])
        csh1, csc1, cg1, csh2, csc2, cg2 = adaln(c_ctx, w_mod[l], b_mod[l])

        h = modulate(rms_norm(x, norm1_g[l]), sh1, sc1)
        hc = modulate(rms_norm(xc, norm1_g[l]), csh1, csc1)
        q, k, v, up, ca, cb = project_inputs(h, w_in[l], q_norm_g[l], k_norm_g[l])
        qc, kc, vc, upc, cac, cbc = project_inputs(hc, w_in[l], q_norm_g[l], k_norm_g[l])
        q = apply_rope(q, cos, sin)
        k = apply_rope(k, cos, sin)
        k_all = jnp.concatenate([kc, k], axis=3)
        v_all = jnp.concatenate([vc, v], axis=2)
        attn = diff_attn_post(diff_attention(q, k_all, v_all, lam), subln_g[l], lambda_init)
        pool_o = pool_mixer(up, pool_w[l], pool_scale[l])
        conv_o = conformer_conv(ca, cb, conv_dw_w[l], conv_dw_b[l], conv_ln_g[l], conv_ln_b[l])
        mix = jnp.concatenate([attn, pool_o, conv_o], axis=-1)
        x = x + g1 * jnp.einsum('blm,md->bld', mix, w_out[l])

        x = x + g2 * swiglu(modulate(rms_norm(x, norm2_g[l]), sh2, sc2), w_ffn_in[l], w_ffn_out[l])

        if not last:
            attn_c = diff_attn_post(diff_attention(qc, kc, vc, lam), subln_g[l], lambda_init)
            pool_c = pool_mixer(upc, pool_w[l], pool_scale[l])
            conv_c = conformer_conv(cac, cbc, conv_dw_w[l], conv_dw_b[l], conv_ln_g[l], conv_ln_b[l])
            mix_c = jnp.concatenate([attn_c, pool_c, conv_c], axis=-1)
            xc = xc + cg1 * jnp.einsum('blm,md->bld', mix_c, w_out[l])
            xc = xc + cg2 * swiglu(modulate(rms_norm(xc, norm2_g[l]), csh2, csc2),
                                   w_ffn_in[l], w_ffn_out[l])
    return x
```

```cpp
#include <hip/hip_runtime.h>
#include <hip/hip_cooperative_groups.h>
#include <cstdio>
#include <cstdint>
namespace cg = cooperative_groups;
namespace pg8 {
#define PG8_LAS __attribute__((address_space(3)))
typedef unsigned short bf16_t;
typedef short bf16x8 __attribute__((ext_vector_type(8)));
typedef float f32x4 __attribute__((ext_vector_type(4)));
typedef unsigned u32x4 __attribute__((ext_vector_type(4)));
constexpr int BM = 256, BK = 64, HALF = 128, HTB = HALF * BK * 2  , STAGE_BYTES = 8 * HTB, NXCD = 8, WGM = 8;

__host__ __device__ __forceinline__ int lds_byte(int r, int c) { const int st = (r >> 4) * 2 + (c >> 5), rr = r & 15, cc = c & 31, ob = rr * 64 + cc * 2; return st * 1024 + (ob ^ (((ob >> 9) & 1) << 5)); }
__host__ __device__ __forceinline__ void stage_rc(int b, int& R, int& C) { const int st = b / 1024, sb = b % 1024, swz = sb ^ (((sb >> 9) & 1) << 5); R = (st >> 1) * 16 + swz / 64; C = (st & 1) * 32 + (swz % 64) / 2; }
__host__ __device__ __forceinline__ int perm32(int rho) { const int n = rho >> 4, i = rho & 15; return 8 * (i >> 2) + 4 * n + (i & 3); }

struct Unit { int pm, pn; };
struct Gemm { const bf16_t* A; const bf16_t* Bt; int M, N, K; };

struct StaticOrder {
    int nM, nN, nwg, G, c;
    __host__ __device__ void init(int M, int N, int G_, int c_) { nM = M / BM; nN = N / BM; nwg = nM * nN; G = G_; c = c_; }
    __host__ __device__ bool next(int i, Unit& u) const {
        const long L = (long)i * G + c; if (L >= nwg) return false;
        int wgid = (int)L; { const int q = nwg / NXCD, r = nwg % NXCD, xcd = wgid % NXCD, off = wgid / NXCD; wgid = (xcd < r ? xcd * (q + 1) : r * (q + 1) + (xcd - r) * q) + off; }
        const int nig = WGM * nN, gid = wgid / nig, fm = gid * WGM, gsz = (nM - fm) < WGM ? (nM - fm) : WGM;
        u.pm = fm + ((wgid % nig) % gsz); u.pn = (wgid % nig) / gsz; return true;
    }
    __device__ __forceinline__ void a_ready(const Unit&) const {}
    __device__ __forceinline__ void done(const Unit&) const {}
};

__device__ __forceinline__ unsigned cvt_pk_bf16(float lo, float hi) { unsigned r; asm volatile("v_cvt_pk_bf16_f32 %0, %1, %2" : "=v"(r) : "v"(lo), "v"(hi)); return r; }
typedef float f32x2 __attribute__((ext_vector_type(2)));
template <class Epi, class Sched, bool ALIGN_EPI = false, bool SP2 = false>
__device__ __forceinline__ void gemm_phase(PG8_LAS unsigned char* lds, const Gemm g, const Sched& S, const Epi& E) {
    int tid_l = threadIdx.x; asm volatile("" : "+v"(tid_l)); const int tid = tid_l, wid = __builtin_amdgcn_readfirstlane(tid >> 6), lane = tid & 63, wr = wid >> 2, wc = wid & 3, fr = lane & 15, fq = lane >> 4;
    const int K = g.K, nt = K / BK;
    unsigned voffA[2], voffB[2];
#pragma unroll
    for (int i = 0; i < 2; ++i) { int R, C; stage_rc(tid * 16 + i * 8192, R, C); const int Rb = Epi::PERM ? ((R & ~31) + perm32(R & 31)) : R;
        voffA[i] = (unsigned)(R * K + C) * 2u; voffB[i] = (unsigned)(Rb * K + C) * 2u; }
    const size_t kstep = (size_t)(BK * 2);
    const size_t hstep = (size_t)HALF * K * 2;
    const size_t tstep = 2 * hstep;
    const unsigned ldsw = (unsigned)wid * 1024u;
    const int aoff = lds_byte(wr * 64 + fr, fq * 8), boff = lds_byte(wc * 32 + fr, fq * 8);
#define PG8_SA(b, h) (((b) * 2 + (h)) * HTB)
#define PG8_SB(b, h) ((4 + (b) * 2 + (h)) * HTB)
#define PG8_STAGE(bufoff, gbase, voff) do { _Pragma("unroll") for (int _i = 0; _i < 2; ++_i) \
        __builtin_amdgcn_global_load_lds((const unsigned*)((const char*)(gbase) + (voff)[_i]), (PG8_LAS unsigned*)(lds + (bufoff) + ldsw + _i * 8192), 16, 0, 0); } while (0)
#define PG8_LDA(dst, b, h) do { _Pragma("unroll") for (int m = 0; m < 4; ++m) _Pragma("unroll") for (int k = 0; k < 2; ++k) dst[m][k] = *(const PG8_LAS bf16x8*)(lds + PG8_SA(b, h) + aoff + m * 2048 + k * 1024); } while (0)
#define PG8_LDB(dst, b, h) do { _Pragma("unroll") for (int n = 0; n < 2; ++n) _Pragma("unroll") for (int k = 0; k < 2; ++k) dst[n][k] = *(const PG8_LAS bf16x8*)(lds + PG8_SB(b, h) + boff + n * 2048 + k * 1024); } while (0)
#define PG8_MMA(ai, bj, At, Bt) do { __builtin_amdgcn_s_setprio(1); _Pragma("unroll") for (int m = 0; m < 4; ++m) _Pragma("unroll") for (int n = 0; n < 2; ++n) _Pragma("unroll") for (int k = 0; k < 2; ++k) \
        acc[ai][bj][m][n] = __builtin_amdgcn_mfma_f32_16x16x32_bf16(Bt[n][k], At[m][k], acc[ai][bj][m][n], 0, 0, 0); __builtin_amdgcn_s_setprio(0); } while (0)
#define PG8_WAIT_V(n) asm volatile("s_waitcnt vmcnt(" #n ")" ::: "memory")
#define PG8_WAIT_L(n) asm volatile("s_waitcnt lgkmcnt(" #n ")" ::: "memory")
#define PG8_BAR __builtin_amdgcn_s_barrier()
#define PG8_SCHED __builtin_amdgcn_sched_barrier(0)
    Unit cur, nxt; int ui = 0;
    if (!S.next(0, cur)) return;
    f32x4 acc[2][2][4][2];
#pragma unroll
    for (int a = 0; a < 2; ++a)
#pragma unroll
        for (int b = 0; b < 2; ++b)
#pragma unroll
            for (int m = 0; m < 4; ++m)
#pragma unroll
                for (int n = 0; n < 2; ++n) acc[a][b][m][n] = (f32x4){0.f, 0.f, 0.f, 0.f};
    bf16x8 At[4][2], B0[2][2], B1[2][2];
    const char* cA = (const char*)g.A + (size_t)cur.pm * tstep; const char* cB = (const char*)g.Bt + (size_t)cur.pn * tstep;
    S.a_ready(cur);
    if constexpr (SP2) {
        PG8_STAGE(PG8_SB(0, 0), cB, voffB); PG8_STAGE(PG8_SB(0, 1), cB + hstep, voffB); PG8_STAGE(PG8_SA(0, 0), cA, voffA); PG8_STAGE(PG8_SA(0, 1), cA + hstep, voffA);
        if (wr == 1) PG8_BAR;
        PG8_WAIT_V(2); PG8_BAR;
        PG8_STAGE(PG8_SB(1, 0), cB + kstep, voffB); PG8_STAGE(PG8_SA(1, 0), cA + kstep, voffA); PG8_STAGE(PG8_SB(1, 1), cB + hstep + kstep, voffB);
        PG8_WAIT_V(6); PG8_BAR;
    } else {
        PG8_STAGE(PG8_SB(0, 0), cB, voffB); PG8_STAGE(PG8_SA(0, 0), cA, voffA); PG8_STAGE(PG8_SB(0, 1), cB + hstep, voffB); PG8_STAGE(PG8_SA(0, 1), cA + hstep, voffA);
        if (wr == 1) PG8_BAR;
        PG8_WAIT_V(4); PG8_BAR;
        PG8_STAGE(PG8_SB(1, 0), cB + kstep, voffB); PG8_STAGE(PG8_SA(1, 0), cA + kstep, voffA); PG8_STAGE(PG8_SB(1, 1), cB + hstep + kstep, voffB);
        PG8_WAIT_V(6); PG8_BAR;
    }
    for (;;) {
        const bool has_next = S.next(ui + 1, nxt);
        const char* nA = has_next ? (const char*)g.A + (size_t)nxt.pm * tstep : cA; const char* nB = has_next ? (const char*)g.Bt + (size_t)nxt.pn * tstep : cB;
        for (int t = 0; t < nt; t += 2) {
            const bool last = (t == nt - 2);
            const char* a1 = cA + (size_t)(t + 1) * kstep;
            const char* a2 = last ? nA : cA + (size_t)(t + 2) * kstep; const char* b2 = last ? nB : cB + (size_t)(t + 2) * kstep;
            const char* a3 = a2 + kstep; const char* b3 = b2 + kstep;
            if (last && has_next) S.a_ready(nxt);
            if constexpr (SP2) {
            PG8_LDB(B0, 0, 0); PG8_LDB(B1, 0, 1); PG8_SCHED; PG8_LDA(At, 0, 0); PG8_STAGE(PG8_SA(1, 1), a1 + hstep, voffA);
            PG8_WAIT_V(8); PG8_WAIT_L(0); PG8_BAR; PG8_MMA(0, 0, At, B0); PG8_MMA(0, 1, At, B1); PG8_BAR; PG8_SCHED;
            PG8_LDA(At, 0, 1); PG8_STAGE(PG8_SB(0, 0), b2, voffB); PG8_STAGE(PG8_SB(0, 1), b2 + hstep, voffB); PG8_STAGE(PG8_SA(0, 0), a2, voffA);
            PG8_WAIT_V(8); PG8_WAIT_L(0); PG8_BAR; PG8_MMA(1, 0, At, B0); PG8_MMA(1, 1, At, B1); PG8_BAR; PG8_SCHED;
            PG8_LDB(B0, 1, 0); PG8_LDB(B1, 1, 1); PG8_SCHED; PG8_LDA(At, 1, 0); PG8_STAGE(PG8_SA(0, 1), a2 + hstep, voffA);
            PG8_WAIT_V(8); PG8_WAIT_L(0); PG8_BAR; PG8_MMA(0, 0, At, B0); PG8_MMA(0, 1, At, B1); PG8_BAR; PG8_SCHED;
            PG8_LDA(At, 1, 1); PG8_STAGE(PG8_SB(1, 0), b3, voffB); PG8_STAGE(PG8_SB(1, 1), b3 + hstep, voffB); PG8_STAGE(PG8_SA(1, 0), a3, voffA);
            PG8_WAIT_V(8); PG8_WAIT_L(0); PG8_BAR; PG8_MMA(1, 0, At, B0); PG8_MMA(1, 1, At, B1); PG8_BAR; PG8_SCHED;
            } else {
            PG8_LDB(B0, 0, 0); PG8_SCHED; PG8_LDA(At, 0, 0); PG8_STAGE(PG8_SA(1, 1), a1 + hstep, voffA);
            PG8_WAIT_L(8); PG8_BAR; PG8_WAIT_L(0); PG8_MMA(0, 0, At, B0); PG8_BAR; PG8_SCHED;
            PG8_LDB(B1, 0, 1); PG8_STAGE(PG8_SB(0, 0), b2, voffB);
            PG8_BAR; PG8_WAIT_L(0); PG8_MMA(0, 1, At, B1); PG8_BAR;
            PG8_LDA(At, 0, 1); PG8_STAGE(PG8_SA(0, 0), a2, voffA);
            PG8_BAR; PG8_WAIT_L(0); PG8_MMA(1, 0, At, B0); PG8_BAR; PG8_SCHED;
            PG8_STAGE(PG8_SB(0, 1), b2 + hstep, voffB);
            PG8_WAIT_V(6); PG8_BAR; PG8_MMA(1, 1, At, B1); PG8_BAR;
            PG8_LDB(B0, 1, 0); PG8_SCHED; PG8_LDA(At, 1, 0); PG8_STAGE(PG8_SA(0, 1), a2 + hstep, voffA);
            PG8_WAIT_L(8); PG8_BAR; PG8_WAIT_L(0); PG8_MMA(0, 0, At, B0); PG8_BAR; PG8_SCHED;
            PG8_LDB(B1, 1, 1); PG8_STAGE(PG8_SB(1, 0), b3, voffB);
            PG8_BAR; PG8_WAIT_L(0); PG8_MMA(0, 1, At, B1); PG8_BAR;
            PG8_LDA(At, 1, 1); PG8_STAGE(PG8_SA(1, 0), a3, voffA);
            PG8_BAR; PG8_WAIT_L(0); PG8_MMA(1, 0, At, B0); PG8_BAR; PG8_SCHED;
            PG8_STAGE(PG8_SB(1, 1), b3 + hstep, voffB);
            PG8_WAIT_V(6); PG8_BAR; PG8_MMA(1, 1, At, B1); PG8_BAR;
            }
        }
        if constexpr (ALIGN_EPI) { if (wr == 0) PG8_BAR; }
        if constexpr (!Epi::AFTER_DRAIN) { E(acc, cur, wr, wc, fr, fq); S.done(cur); }
        if (!has_next) break;
#pragma unroll
        for (int a = 0; a < 2; ++a)
#pragma unroll
            for (int b = 0; b < 2; ++b)
#pragma unroll
                for (int m = 0; m < 4; ++m)
#pragma unroll
                    for (int n = 0; n < 2; ++n) acc[a][b][m][n] = (f32x4){0.f, 0.f, 0.f, 0.f};
        cur = nxt; cA = nA; cB = nB; ++ui;
        if constexpr (ALIGN_EPI) { if (wr == 1) PG8_BAR; }
    }
    PG8_WAIT_V(0);
    if constexpr (!ALIGN_EPI) { if (wr == 0) PG8_BAR; }
    PG8_BAR;
    if constexpr (Epi::AFTER_DRAIN) { E.fused(acc, cur, wr, wc, fr, fq, lds, wid, lane); S.done(cur); }
#undef PG8_SA
#undef PG8_SB
#undef PG8_STAGE
#undef PG8_LDA
#undef PG8_LDB
#undef PG8_MMA
#undef PG8_WAIT_V
#undef PG8_WAIT_L
#undef PG8_BAR
#undef PG8_SCHED
}
}
#define LAS __attribute__((address_space(3)))
#define XB_TMO      128
#define XB_XCNT(j)  (256  + 64 * (j))
#define XB_XSUB(j)  (1280 + 64 * (j))
#define XB_XGEN(j)  (2304 + 64 * (j))
#define XB_TOP      3328
#define XB_TOPGEN   3392
#define XCD_BAR_WORDS 3456
#define XB_SPIN_CAP (1u << 18)

__device__ __forceinline__ unsigned xb_ld(unsigned* p)              { return __hip_atomic_load(p, __ATOMIC_RELAXED, __HIP_MEMORY_SCOPE_AGENT); }
__device__ __forceinline__ unsigned xb_add(unsigned* p, unsigned v) { return __hip_atomic_fetch_add(p, v, __ATOMIC_RELAXED, __HIP_MEMORY_SCOPE_AGENT); }
__device__ __forceinline__ unsigned xb_xcc_id() { return (unsigned)__builtin_amdgcn_s_getreg((3 << 11) | 20) & 0xFu; }
#define XB_SPIN(cond, bar) do { unsigned _sp = 0; while (cond) { __builtin_amdgcn_s_sleep(1); \
    if ((++_sp & 255u) == 0u) { if (xb_ld(&(bar)[XB_TMO])) break; if (_sp > XB_SPIN_CAP) { atomicAdd(&(bar)[XB_TMO], 1u); break; } } } } while (0)

struct XcdBarrier {
    unsigned* bar; unsigned x;
    volatile LAS unsigned* st;
};

__device__ __forceinline__ XcdBarrier xcd_barrier_post(unsigned* bar, volatile LAS unsigned* st) {
    XcdBarrier b; b.bar = bar; b.x = xb_xcc_id(); b.st = st;
    if (threadIdx.x == 0) (void)xb_add(&bar[XB_XCNT(b.x)], 1u);
    return b;
}
__device__ __forceinline__ void xcd_barrier_complete(unsigned* bar, unsigned x, unsigned& nloc, unsigned& nx) {
    const unsigned G = gridDim.x * gridDim.y * gridDim.z;
    unsigned sum, cnt, mine, sp = 0u;
    for (;;) {
        sum = 0u; cnt = 0u; mine = 0u;
#pragma unroll
        for (unsigned j = 0; j < 16; ++j) { const unsigned c = xb_ld(&bar[XB_XCNT(j)]); sum += c; cnt += (c > 0u) ? 1u : 0u; mine = (j == x) ? c : mine; }
        if (sum == G) break;
        __builtin_amdgcn_s_sleep(1);
        if ((++sp & 255u) == 0u) { if (xb_ld(&bar[XB_TMO])) break; if (sp > XB_SPIN_CAP) { atomicAdd(&bar[XB_TMO], 1u); break; } }
    }
    nloc = mine > 0u ? mine : 1u; nx = cnt > 0u ? cnt : 1u;
}

__device__ __forceinline__ void xcd_barrier(const XcdBarrier& b) {
    asm volatile("s_waitcnt vmcnt(0)" ::: "memory");
    __syncthreads();
    if (threadIdx.x == 0) {
        unsigned* bar = b.bar;
        __builtin_amdgcn_s_waitcnt(0);
        unsigned nloc = b.st[0], nx = b.st[1];
        if (nloc == 0u) { xcd_barrier_complete(bar, b.x, nloc, nx); b.st[0] = nloc; b.st[1] = nx; }
        const unsigned old = xb_add(&bar[XB_XSUB(b.x)], 1u);
        const unsigned gen = old / nloc;
        if (old + 1u == (gen + 1u) * nloc) {
            __builtin_amdgcn_fence(__ATOMIC_RELEASE, "agent");
            asm volatile("s_waitcnt vmcnt(0)" ::: "memory");
            const unsigned og = xb_add(&bar[XB_TOP], 1u);
            const unsigned tg = og / nx;
            if (og + 1u == (tg + 1u) * nx) xb_add(&bar[XB_TOPGEN], 1u);
            else XB_SPIN(xb_ld(&bar[XB_TOPGEN]) == tg, bar);
            __builtin_amdgcn_fence(__ATOMIC_ACQUIRE, "agent");
            xb_add(&bar[XB_XGEN(b.x)], 1u);
            asm volatile("s_waitcnt vmcnt(0)" ::: "memory");
        } else {
            XB_SPIN(xb_ld(&bar[XB_XGEN(b.x)]) == gen, bar);
            __builtin_amdgcn_fence(__ATOMIC_ACQUIRE, "agent");
            asm volatile("s_waitcnt vmcnt(0)" ::: "memory");
        }
    }
    __syncthreads();
}

using pg8::bf16_t; using pg8::bf16x8; using pg8::f32x4; using pg8::u32x4; using pg8::Unit;
typedef float f32x16 __attribute__((ext_vector_type(16)));
typedef unsigned u32x2 __attribute__((ext_vector_type(2)));
typedef short s16x4 __attribute__((ext_vector_type(4)));
#define LAS __attribute__((address_space(3)))

constexpr int DM = 1024, NB = 2, SEQ = 8192, DEPTH = 4, CTXL = 256;
constexpr int MLAT = NB * SEQ, MCTX = NB * CTXL, MALL = MLAT + MCTX;
constexpr int INW = 2304, FFH = 2816, FFI = 5632;
constexpr int LK = SEQ + CTXL, NTK = LK / 64;
constexpr float EPSN = 1e-6f;
constexpr float QSCALE = 0.125f * 1.4426950408889634f;

constexpr size_t MiB = 1u << 20;
constexpr size_t ZERO_BYTES = 2 * MiB;
constexpr size_t Z_MOD = 0, Z_BIAS1 = 294912, Z_BIAS2 = 405504, Z_ROWSQ = 675840;
constexpr size_t Z_CNT = 1600000;
constexpr size_t Z_BAR = 1572864;
static_assert(Z_ROWSQ + (size_t)8 * MALL * 4 <= Z_BAR && Z_BAR + XCD_BAR_WORDS * 4 <= Z_CNT && Z_CNT + 4 * 256 <= ZERO_BYTES, "zero region");
constexpr size_t WS_ROPE = 2 * MiB, WS_LAM = 2 * MiB + 16384;
constexpr size_t WS_W = 4 * MiB, W_LAYER = 25 * MiB, W_IN = 0, W_OUT = 4718592, W_FI = 6815744, W_FO = 18350080;
constexpr size_t WS_XG = 104 * MiB, WS_Q = 140 * MiB, WS_K = 157 * MiB, WS_V = 174 * MiB, WS_UP = 191 * MiB, WS_UC = 208 * MiB, WS_MIX = 225 * MiB;
constexpr size_t WS_ACT = 140 * MiB, WS_XC = 259 * MiB, WS_END = 262 * MiB;
constexpr int LDS_BYTES = 147456;

struct Params {
    const float *x, *c, *ctx, *c_ctx, *w_mod, *b_mod, *norm1_g, *w_in, *q_norm_g, *k_norm_g, *lq1, *lk1, *lq2, *lk2, *subln_g, *pool_w, *pool_scale,
                *conv_w, *conv_b, *conv_ln_g, *conv_ln_b, *w_out, *norm2_g, *w_ffn_in, *w_ffn_out;
    float* out; unsigned char* ws;
};

__device__ __forceinline__ float wave_sum(float v) {
#pragma unroll
    for (int o = 1; o < 64; o <<= 1) v += __shfl_xor(v, o);
    return v;
}
__device__ __forceinline__ float sigm(float v) { return __builtin_amdgcn_rcpf(1.f + __builtin_amdgcn_exp2f(-1.4426950408889634f * v)); }
__device__ __forceinline__ float siluf(float v) { return v * sigm(v); }
__device__ __forceinline__ unsigned pkbf(float lo, float hi) { return pg8::cvt_pk_bf16(lo, hi); }

__device__ __forceinline__ int perm_in(int cn) {
    const int pn = cn >> 8, pos = cn & 255;
    if (pn < 4) { const int bj = pos >> 7, wc = (pos >> 5) & 3, e = pos & 31; return pn * 256 + wc * 64 + bj * 32 + e; }
    if (pn < 7) return cn;
    return (pos < 128) ? (1792 + 128 * (pn - 7) + pos) : (2048 + 128 * (pn - 7) + pos - 128);
}
__device__ __forceinline__ int perm_fi(int cn) { const int pn = cn >> 8, pos = cn & 255; return (pos < 128) ? (128 * pn + pos) : (FFH + 128 * pn + pos - 128); }

__device__ __forceinline__ int voff(int row, int ch) { return 2048 * (row >> 3) + 512 * (ch >> 2) + 64 * (row & 7) + 16 * ((ch & 3) ^ ((row >> 2) & 3)); }

struct EpiInProj {
    static constexpr bool PERM = true, AFTER_DRAIN = false;
    const float* rowsq; const float* bias; const float* qg; const float* kg; const float* rope;
    bf16_t* Qb; bf16_t* Kb; bf16_t* Vb; float* upool; float* uconv;
    __device__ __forceinline__ void operator()(const f32x4 (&acc)[2][2][4][2], const Unit& u, int wr, int wc, int fr, int fq) const {
        const int pn = u.pn, pm = u.pm;
        const bool isctx = pm >= 64;
        const int v = isctx ? 2 : (pm >> 5);
        const int cb = pn * 256 + wc * 32 + 8 * fq;
        f32x4 bv[2][2];
#pragma unroll
        for (int bj = 0; bj < 2; ++bj)
#pragma unroll
            for (int n = 0; n < 2; ++n) bv[bj][n] = *(const f32x4*)(bias + v * INW + cb + 128 * bj + 4 * n);
        if (pn < 4) {
            const bool isq = pn < 2;
            const float* gp = isq ? qg : kg;
            f32x4 gv[2][2];
#pragma unroll
            for (int bj = 0; bj < 2; ++bj)
#pragma unroll
                for (int n = 0; n < 2; ++n) gv[bj][n] = *(const f32x4*)(gp + 32 * bj + 8 * fq + 4 * n);
            const int hc = (isq ? pn : pn - 2) * 4 + wc;
            bf16_t* dst = isq ? Qb : Kb;
            const float osc = isq ? QSCALE : 1.f;
#pragma unroll
            for (int ai = 0; ai < 2; ++ai)
#pragma unroll
                for (int m = 0; m < 4; ++m) {
                    const int row = pm * 256 + ai * 128 + wr * 64 + m * 16 + fr;
                    const float rinv = rsqrtf(rowsq[row] * (1.f / DM) + EPSN);
                    int b, kidx, t = 0;
                    if (isctx) { const int rc = row - MLAT; b = rc >> 8; kidx = rc & 255; } else { b = row >> 13; t = row & (SEQ - 1); kidx = CTXL + t; }
                    f32x4 val[2][2]; float ss = 0.f;
#pragma unroll
                    for (int bj = 0; bj < 2; ++bj)
#pragma unroll
                        for (int n = 0; n < 2; ++n) { val[bj][n] = acc[ai][bj][m][n] * rinv + bv[bj][n]; const f32x4 q = val[bj][n]; ss += (q[0] * q[0] + q[1] * q[1]) + (q[2] * q[2] + q[3] * q[3]); }
                    ss += __shfl_xor(ss, 16); ss += __shfl_xor(ss, 32);
                    const float rn = rsqrtf(ss * (1.f / 64.f) + EPSN);
#pragma unroll
                    for (int bj = 0; bj < 2; ++bj) {
                        f32x4 y0 = val[bj][0] * rn * gv[bj][0], y1 = val[bj][1] * rn * gv[bj][1];
                        if (!isctx) {
                            const int pos = bj == 0 ? (t >> 6) : (t & 63);
                            const f32x4 r0 = *(const f32x4*)(rope + (size_t)(pos * 16 + 4 * fq) * 2);
                            const f32x4 r1 = *(const f32x4*)(rope + (size_t)(pos * 16 + 4 * fq + 2) * 2);
                            f32x4 z0, z1;
                            z0[0] = y0[0] * r0[0] - y0[1] * r0[1]; z0[1] = y0[0] * r0[1] + y0[1] * r0[0];
                            z0[2] = y0[2] * r0[2] - y0[3] * r0[3]; z0[3] = y0[2] * r0[3] + y0[3] * r0[2];
                            z1[0] = y1[0] * r1[0] - y1[1] * r1[1]; z1[1] = y1[0] * r1[1] + y1[1] * r1[0];
                            z1[2] = y1[2] * r1[2] - y1[3] * r1[3]; z1[3] = y1[2] * r1[3] + y1[3] * r1[2];
                            y0 = z0; y1 = z1;
                        }
                        y0 = y0 * osc; y1 = y1 * osc;
                        u32x4 w; w.x = pkbf(y0[0], y0[1]); w.y = pkbf(y0[2], y0[3]); w.z = pkbf(y1[0], y1[1]); w.w = pkbf(y1[2], y1[3]);
                        const size_t off = (size_t)(b * 8 + hc) * (LK * 64) + (size_t)(kidx >> 6) * 4096 + (size_t)(4 * bj + fq) * 512 + (size_t)(kidx & 63) * 8;
                        *(u32x4*)(dst + off) = w;
                    }
                }
        } else if (pn < 6) {
#pragma unroll
            for (int ai = 0; ai < 2; ++ai)
#pragma unroll
                for (int m = 0; m < 4; ++m) {
                    const int row = pm * 256 + ai * 128 + wr * 64 + m * 16 + fr;
                    const float rinv = rsqrtf(rowsq[row] * (1.f / DM) + EPSN);
                    int b, kidx;
                    if (isctx) { const int rc = row - MLAT; b = rc >> 8; kidx = rc & 255; } else { b = row >> 13; kidx = CTXL + (row & (SEQ - 1)); }
#pragma unroll
                    for (int bj = 0; bj < 2; ++bj) {
                        const f32x4 y0 = acc[ai][bj][m][0] * rinv + bv[bj][0], y1 = acc[ai][bj][m][1] * rinv + bv[bj][1];
                        u32x4 w; w.x = pkbf(y0[0], y0[1]); w.y = pkbf(y0[2], y0[3]); w.z = pkbf(y1[0], y1[1]); w.w = pkbf(y1[2], y1[3]);
                        const int head = 2 * (pn - 4) + bj;
                        const size_t off = (size_t)(b * 4 + head) * (LK * 128) + (size_t)(kidx >> 6) * 8192 + (size_t)(voff(kidx & 63, 4 * wc + fq) >> 1);
                        *(u32x4*)(Vb + off) = w;
                    }
                }
        } else if (pn == 6) {
#pragma unroll
            for (int ai = 0; ai < 2; ++ai)
#pragma unroll
                for (int m = 0; m < 4; ++m) {
                    const int row = pm * 256 + ai * 128 + wr * 64 + m * 16 + fr;
                    const float rinv = rsqrtf(rowsq[row] * (1.f / DM) + EPSN);
#pragma unroll
                    for (int bj = 0; bj < 2; ++bj)
#pragma unroll
                        for (int n = 0; n < 2; ++n) *(f32x4*)(upool + (size_t)row * 256 + 128 * bj + 32 * wc + 8 * fq + 4 * n) = acc[ai][bj][m][n] * rinv + bv[bj][n];
                }
        } else {
            const int ch0 = 128 * (pn - 7) + 32 * wc + 8 * fq;
#pragma unroll
            for (int ai = 0; ai < 2; ++ai)
#pragma unroll
                for (int m = 0; m < 4; ++m) {
                    const int row = pm * 256 + ai * 128 + wr * 64 + m * 16 + fr;
                    const float rinv = rsqrtf(rowsq[row] * (1.f / DM) + EPSN);
#pragma unroll
                    for (int n = 0; n < 2; ++n) {
                        const f32x4 a = acc[ai][0][m][n] * rinv + bv[0][n], g = acc[ai][1][m][n] * rinv + bv[1][n];
                        f32x4 o;
#pragma unroll
                        for (int j = 0; j < 4; ++j) o[j] = a[j] * sigm(g[j]);
                        *(f32x4*)(uconv + (size_t)row * 256 + ch0 + 4 * n) = o;
                    }
                }
        }
    }
};

struct EpiResid {
    static constexpr bool PERM = true, AFTER_DRAIN = false;
    const float* res_lat; const float* res_ctx; float* dst_lat; float* dst_ctx;
    const float* gate;
    const float* ng;
    const float* nsc;
    bf16_t* xg; float* rowsq_next;
    __device__ __forceinline__ void operator()(const f32x4 (&acc)[2][2][4][2], const Unit& u, int wr, int wc, int fr, int fq) const {
        const int pn = u.pn, pm = u.pm;
        const bool isctx = pm >= 64;
        const int v = isctx ? 2 : (pm >> 5);
        const int cb = pn * 256 + wc * 32 + 8 * fq;
        const bool nxt = ng != nullptr;
        f32x4 gt[2][2], gs[2][2];
#pragma unroll
        for (int bj = 0; bj < 2; ++bj)
#pragma unroll
            for (int n = 0; n < 2; ++n) {
                const int col = cb + 128 * bj + 4 * n;
                gt[bj][n] = *(const f32x4*)(gate + v * 6144 + col);
                if (nxt) { const f32x4 a = *(const f32x4*)(ng + col), s = *(const f32x4*)(nsc + v * 6144 + col); gs[bj][n] = a * (s + 1.f); } else gs[bj][n] = (f32x4){0.f, 0.f, 0.f, 0.f};
            }
#pragma unroll
        for (int q2 = 0; q2 < 4; ++q2) {
            const int ai = q2 >> 1, m0 = (q2 & 1) * 2;
            f32x4 pre[2][2][2];
#pragma unroll
            for (int mm = 0; mm < 2; ++mm) {
                const int row = pm * 256 + ai * 128 + wr * 64 + (m0 + mm) * 16 + fr;
                const float* src = isctx ? res_ctx + (size_t)(row - MLAT) * DM : res_lat + (size_t)row * DM;
#pragma unroll
                for (int bj = 0; bj < 2; ++bj) { pre[mm][bj][0] = *(const f32x4*)(src + cb + 128 * bj); pre[mm][bj][1] = *(const f32x4*)(src + cb + 128 * bj + 4); }
            }
#pragma unroll
            for (int mm = 0; mm < 2; ++mm) {
                const int m = m0 + mm;
                const int row = pm * 256 + ai * 128 + wr * 64 + m * 16 + fr;
                float* dst = isctx ? dst_ctx + (size_t)(row - MLAT) * DM : dst_lat + (size_t)row * DM;
                float ss = 0.f;
#pragma unroll
                for (int bj = 0; bj < 2; ++bj) {
                    const int col = cb + 128 * bj;
                    const f32x4 x0 = pre[mm][bj][0] + gt[bj][0] * acc[ai][bj][m][0];
                    const f32x4 x1 = pre[mm][bj][1] + gt[bj][1] * acc[ai][bj][m][1];
                    *(f32x4*)(dst + col) = x0; *(f32x4*)(dst + col + 4) = x1;
                    if (nxt) {
                        ss += (x0[0] * x0[0] + x0[1] * x0[1]) + (x0[2] * x0[2] + x0[3] * x0[3]) + (x1[0] * x1[0] + x1[1] * x1[1]) + (x1[2] * x1[2] + x1[3] * x1[3]);
                        const f32x4 y0 = x0 * gs[bj][0], y1 = x1 * gs[bj][1];
                        u32x4 w; w.x = pkbf(y0[0], y0[1]); w.y = pkbf(y0[2], y0[3]); w.z = pkbf(y1[0], y1[1]); w.w = pkbf(y1[2], y1[3]);
                        *(u32x4*)(xg + (size_t)row * DM + col) = w;
                    }
                }
                if (nxt) { ss += __shfl_xor(ss, 16); ss += __shfl_xor(ss, 32); if (fq == 0) unsafeAtomicAdd(rowsq_next + row, ss); }
            }
        }
    }
};

struct EpiSwiGLU {
    static constexpr bool PERM = true, AFTER_DRAIN = false;
    const float* rowsq; const float* bias; bf16_t* act;
    __device__ __forceinline__ void operator()(const f32x4 (&acc)[2][2][4][2], const Unit& u, int wr, int wc, int fr, int fq) const {
        const int pn = u.pn, pm = u.pm;
        const int v = pm >= 64 ? 2 : (pm >> 5);
        const int cb = pn * 256 + wc * 32 + 8 * fq;
        f32x4 bv[2][2];
#pragma unroll
        for (int bj = 0; bj < 2; ++bj)
#pragma unroll
            for (int n = 0; n < 2; ++n) bv[bj][n] = *(const f32x4*)(bias + v * FFI + cb + 128 * bj + 4 * n);
#pragma unroll
        for (int ai = 0; ai < 2; ++ai)
#pragma unroll
            for (int m = 0; m < 4; ++m) {
                const int row = pm * 256 + ai * 128 + wr * 64 + m * 16 + fr;
                const float rinv = rsqrtf(rowsq[row] * (1.f / DM) + EPSN);
                f32x4 o[2];
#pragma unroll
                for (int n = 0; n < 2; ++n) {
                    const f32x4 g = acc[ai][0][m][n] * rinv + bv[0][n], up = acc[ai][1][m][n] * rinv + bv[1][n];
#pragma unroll
                    for (int j = 0; j < 4; ++j) o[n][j] = g[j] * sigm(g[j]) * up[j];
                }
                u32x4 w; w.x = pkbf(o[0][0], o[0][1]); w.y = pkbf(o[0][2], o[0][3]); w.z = pkbf(o[1][0], o[1][1]); w.w = pkbf(o[1][2], o[1][3]);
                *(u32x4*)(act + (size_t)row * FFH + pn * 128 + wc * 32 + 8 * fq) = w;
            }
    }
};

#define AT_WAITV(n) asm volatile("s_waitcnt vmcnt(" #n ")" ::: "memory")
__device__ __forceinline__ void glds16(const void* gsrc, unsigned lds_dst) { unsigned keep;
    asm volatile("s_mov_b32 %0, m0\n\ts_mov_b32 m0, %2\n\ts_nop 0\n\tglobal_load_lds_dwordx4 %1, off\n\ts_mov_b32 m0, %0" : "=&s"(keep) : "v"(gsrc), "s"(lds_dst) : "memory"); }
__device__ __forceinline__ void glds16s(unsigned voff, const void* sbase, unsigned lds_dst) { unsigned keep;
    asm volatile("s_mov_b32 %0, m0\n\ts_mov_b32 m0, %3\n\ts_nop 0\n\tglobal_load_lds_dwordx4 %1, %2\n\ts_mov_b32 m0, %0" : "=&s"(keep) : "v"(voff), "s"(sbase), "s"(lds_dst) : "memory"); }
__device__ __forceinline__ s16x4 tr16(const LAS unsigned char* p) { return __builtin_bit_cast(s16x4, __builtin_amdgcn_ds_read_tr16_b64_v4i16((LAS s16x4*)p)); }

#define AT_SB() __builtin_amdgcn_sched_barrier(0)
__device__ __forceinline__ float fadd_s(float a, float b) { float r; asm("v_add_f32_e32 %0, %1, %2" : "=v"(r) : "v"(a), "v"(b)); return r; }
#define AT_WAIT_BAR(N) asm volatile("s_waitcnt vmcnt(" #N ") lgkmcnt(0)\n\ts_barrier" ::: "memory")
__device__ __forceinline__ void attn_unit(LAS unsigned char* lds, const bf16_t* Qb, const bf16_t* Kb, const bf16_t* Vb, bf16_t* mix,
                                          int b, int head, int qbase  , float lam, float post_scale, const float* subg) {
    int tid_l = threadIdx.x; asm volatile("" : "+v"(tid_l)); const int tid = tid_l, lane = tid & 63, wid = __builtin_amdgcn_readfirstlane(tid >> 6);
    const int r = lane & 31, h = lane >> 5;
    const int qg = wid & 3, c = wid >> 2;
    const int NT = qbase < CTXL ? (CTXL / 64) : NTK;
    const int qidx = qbase + qg * 32 + r;
    const size_t bh = (size_t)(b * 4 + head);
    const bf16_t* Qc = Qb + (bh * 2 + c) * (LK * 64);
    const unsigned char* K0 = (const unsigned char*)(Kb + (bh * 2) * (LK * 64));
    const unsigned char* V0 = (const unsigned char*)(Vb + bh * (LK * 128));
    const unsigned goff = (unsigned)(wid * 1024 + lane * 16);
    const unsigned ldsb = (unsigned)(size_t)lds;
    constexpr int VRING = 65536;
#define AT_DMA_K(t, slot) do { const unsigned _d = (unsigned)__builtin_amdgcn_readfirstlane((int)(ldsb + (unsigned)((slot) * 16384 + wid * 1024))); \
        glds16s(goff, K0 + (size_t)(t) * 8192, _d); glds16s(goff, K0 + (size_t)(LK * 128) + (size_t)(t) * 8192, _d + 8192u); } while (0)
#define AT_DMA_V(t, slot) do { const unsigned _d = (unsigned)__builtin_amdgcn_readfirstlane((int)(ldsb + (unsigned)(VRING + (slot) * 16384 + wid * 1024))); \
        glds16s(goff, V0 + (size_t)(t) * 16384, _d); glds16s(goff, V0 + (size_t)(t) * 16384 + 8192, _d + 8192u); } while (0)
    AT_DMA_K(0, 0); AT_DMA_V(0, 0); AT_DMA_K(1, 1);
    bf16x8 q[4];
#pragma unroll
    for (int d0 = 0; d0 < 4; ++d0) q[d0] = *(const bf16x8*)(Qc + (size_t)(qidx >> 6) * 4096 + (size_t)(2 * d0 + h) * 512 + (size_t)(qidx & 63) * 8);
    AT_DMA_K(2, 2);
    f32x16 O[4];
#pragma unroll
    for (int d = 0; d < 4; ++d)
#pragma unroll
        for (int i = 0; i < 16; ++i) O[d][i] = 0.f;
    float lsum = 0.f;
    const int koff = c * 8192 + h * 1024 + r * 16;
    const int g1 = (lane >> 4) & 1, qq = (lane & 15) >> 2, pp = lane & 3;
    const int vlo = VRING + 64 * (4 * h + qq) + 16 * (2 * g1 + ((pp >> 1) ^ h)) + 8 * (pp & 1);
    const int vhi = VRING + 2048 + 64 * (4 * h + qq) + 16 * (2 * (g1 ^ 1) + ((pp >> 1) ^ h)) + 8 * (pp & 1);
    bf16x8 kf[8];
#define AT_KLOAD2(j, slot) do { kf[2 * (j)] = *(const LAS bf16x8*)(lds + (slot) * 16384 + koff + (j) * 2048); kf[2 * (j) + 1] = *(const LAS bf16x8*)(lds + (slot) * 16384 + koff + (j) * 2048 + 512); } while (0)
#define AT_VFRAG(dst, vp, n) do { const s16x4 lo_ = tr16((vp) + vlo + ((n) >> 2) * 4096 + ((n) & 3) * 512), hi_ = tr16((vp) + vhi + ((n) >> 2) * 4096 + ((n) & 3) * 512); \
        dst = (bf16x8){lo_[0], lo_[1], lo_[2], lo_[3], hi_[0], hi_[1], hi_[2], hi_[3]}; } while (0)
    f32x16 pA0, pA1, pB0, pB1;
    u32x4 pw0, pw1, pw2, pw3;
    const f32x16 zero16 = {0.f, 0.f, 0.f, 0.f, 0.f, 0.f, 0.f, 0.f, 0.f, 0.f, 0.f, 0.f, 0.f, 0.f, 0.f, 0.f};
    int sl_prev = 0, sl_cur = 0, sl_next = 1;
#define AT_ROT() do { sl_prev = sl_cur; sl_cur = sl_next; sl_next = (sl_next == 2) ? 0 : sl_next + 1; } while (0)
    AT_WAIT_BAR(6);
    AT_KLOAD2(0, 0); AT_KLOAD2(1, 0); AT_KLOAD2(2, 0); AT_KLOAD2(3, 0);
    pA0 = __builtin_amdgcn_mfma_f32_32x32x16_bf16(kf[0], q[0], zero16, 0, 0, 0); pA1 = __builtin_amdgcn_mfma_f32_32x32x16_bf16(kf[1], q[0], zero16, 0, 0, 0);
#pragma unroll
    for (int d0 = 1; d0 < 4; ++d0) { pA0 = __builtin_amdgcn_mfma_f32_32x32x16_bf16(kf[2 * d0], q[d0], pA0, 0, 0, 0); pA1 = __builtin_amdgcn_mfma_f32_32x32x16_bf16(kf[2 * d0 + 1], q[d0], pA1, 0, 0, 0); }
#pragma unroll
    for (int i = 0; i < 16; ++i) { pA0[i] = __builtin_amdgcn_exp2f(pA0[i]); pA1[i] = __builtin_amdgcn_exp2f(pA1[i]); }
    AT_WAIT_BAR(0);
    AT_DMA_K(3, 3); AT_DMA_V(1, 1);
    AT_ROT();
    AT_KLOAD2(0, 1); AT_KLOAD2(1, 1);
    AT_WAIT_BAR(4);
#define AT_PK(P, B) pkbf(P[B], P[B + 1])
#define AT_GAPA(MF, P, B, PW, X, Y) do { MF; sacc = fadd_s(sacc, P[B]); sacc = fadd_s(sacc, P[B + 1]); sacc = fadd_s(sacc, P[B + 2]); sacc = fadd_s(sacc, P[B + 3]); PW.X = AT_PK(P, B); PW.Y = AT_PK(P, B + 2); AT_SB(); } while (0)
#define AT_GAPB(n, C, B) do { if ((n) + 2 < 16) AT_VFRAG(vfr[((n) + 2) % 3], vp_, (n) + 2); \
        O[(n) & 3] = __builtin_amdgcn_mfma_f32_32x32x16_bf16(vfr[(n) % 3], __builtin_bit_cast(bf16x8, pwv[(n) >> 2]), O[(n) & 3], 0, 0, 0); \
        C[B] = __builtin_amdgcn_exp2f(C[B]); C[B + 1] = __builtin_amdgcn_exp2f(C[B + 1]); AT_SB(); } while (0)
#define AT_STEP(C0, C1, P0, P1, t, GK, GV, GL) do { AT_SB(); \
        const LAS unsigned char* vp_ = lds + sl_prev * 16384; float sacc = 0.f; \
        AT_KLOAD2(2, (t) & 3); AT_KLOAD2(3, (t) & 3); AT_SB(); \
        AT_GAPA(C0 = __builtin_amdgcn_mfma_f32_32x32x16_bf16(kf[0], q[0], zero16, 0, 0, 0), P0, 0, pw0, x, y); \
        AT_GAPA(C1 = __builtin_amdgcn_mfma_f32_32x32x16_bf16(kf[1], q[0], zero16, 0, 0, 0), P0, 4, pw0, z, w); \
        AT_GAPA(C0 = __builtin_amdgcn_mfma_f32_32x32x16_bf16(kf[2], q[1], C0, 0, 0, 0), P0, 8, pw1, x, y); \
        AT_GAPA(C1 = __builtin_amdgcn_mfma_f32_32x32x16_bf16(kf[3], q[1], C1, 0, 0, 0), P0, 12, pw1, z, w); \
        AT_GAPA(C0 = __builtin_amdgcn_mfma_f32_32x32x16_bf16(kf[4], q[2], C0, 0, 0, 0), P1, 0, pw2, x, y); \
        AT_GAPA(C1 = __builtin_amdgcn_mfma_f32_32x32x16_bf16(kf[5], q[2], C1, 0, 0, 0), P1, 4, pw2, z, w); \
        bf16x8 vfr[3]; AT_VFRAG(vfr[0], vp_, 0); AT_VFRAG(vfr[1], vp_, 1); AT_SB(); \
        AT_GAPA(C0 = __builtin_amdgcn_mfma_f32_32x32x16_bf16(kf[6], q[3], C0, 0, 0, 0), P1, 8, pw3, x, y); \
        AT_GAPA(C1 = __builtin_amdgcn_mfma_f32_32x32x16_bf16(kf[7], q[3], C1, 0, 0, 0), P1, 12, pw3, z, w); \
        lsum += sacc; \
        if (GK) AT_DMA_K((t) + 3, ((t) + 3) & 3); if (GV) AT_DMA_V((t) + 1, sl_next); \
        const u32x4 pwv[4] = {pw0, pw1, pw2, pw3}; AT_SB(); \
        AT_GAPB(0, C0, 0); AT_GAPB(1, C0, 2); AT_GAPB(2, C0, 4); AT_GAPB(3, C0, 6); \
        if (GL) { AT_KLOAD2(0, ((t) + 1) & 3); AT_SB(); } AT_GAPB(4, C0, 8); \
        if (GL) { AT_KLOAD2(1, ((t) + 1) & 3); AT_SB(); } AT_GAPB(5, C0, 10); \
        AT_GAPB(6, C0, 12); AT_GAPB(7, C0, 14); \
        AT_GAPB(8, C1, 0); AT_GAPB(9, C1, 2); AT_GAPB(10, C1, 4); AT_GAPB(11, C1, 6); AT_GAPB(12, C1, 8); AT_GAPB(13, C1, 10); AT_GAPB(14, C1, 12); AT_GAPB(15, C1, 14); \
    } while (0)
#define AT_ENDW(tt) do { if ((tt) + 3 < NT) { AT_WAIT_BAR(4); } else if ((tt) + 2 < NT) { AT_WAIT_BAR(2); } else { AT_WAIT_BAR(0); } } while (0)
    int t = 1;
    for (; t + 5 < NT; t += 2) {
        AT_STEP(pB0, pB1, pA0, pA1, t, true, true, true);     AT_WAIT_BAR(4); AT_ROT();
        AT_STEP(pA0, pA1, pB0, pB1, t + 1, true, true, true); AT_WAIT_BAR(4); AT_ROT();
    }
    for (; t + 1 < NT; t += 2) {
        AT_STEP(pB0, pB1, pA0, pA1, t, (t + 3 < NT), (t + 1 < NT), (t + 1 < NT));         AT_ENDW(t);     AT_ROT();
        AT_STEP(pA0, pA1, pB0, pB1, t + 1, (t + 4 < NT), (t + 2 < NT), (t + 2 < NT));     AT_ENDW(t + 1); AT_ROT();
    }
    AT_STEP(pB0, pB1, pA0, pA1, NT - 1, false, false, false);
    {
        float sacc = 0.f;
#pragma unroll
        for (int i = 0; i < 16; ++i) sacc += pB0[i] + pB1[i];
        lsum += sacc;
        pw0 = (u32x4){AT_PK(pB0, 0), AT_PK(pB0, 2), AT_PK(pB0, 4), AT_PK(pB0, 6)}; pw1 = (u32x4){AT_PK(pB0, 8), AT_PK(pB0, 10), AT_PK(pB0, 12), AT_PK(pB0, 14)};
        pw2 = (u32x4){AT_PK(pB1, 0), AT_PK(pB1, 2), AT_PK(pB1, 4), AT_PK(pB1, 6)}; pw3 = (u32x4){AT_PK(pB1, 8), AT_PK(pB1, 10), AT_PK(pB1, 12), AT_PK(pB1, 14)};
        const u32x4 pwv[4] = {pw0, pw1, pw2, pw3};
        const LAS unsigned char* vp_ = lds + sl_cur * 16384;
#pragma unroll
        for (int n = 0; n < 16; ++n) { bf16x8 vf_; AT_VFRAG(vf_, vp_, n); O[n & 3] = __builtin_amdgcn_mfma_f32_32x32x16_bf16(vf_, __builtin_bit_cast(bf16x8, pwv[n >> 2]), O[n & 3], 0, 0, 0); }
    }
#undef AT_STEP
#undef AT_GAPA
#undef AT_GAPB
#undef AT_ENDW
#undef AT_PK
#undef AT_ROT
#undef AT_KLOAD2
#undef AT_VFRAG
#undef AT_DMA_K
#undef AT_DMA_V
    asm volatile("s_waitcnt vmcnt(0) lgkmcnt(0)" ::: "memory");
    __builtin_amdgcn_s_barrier();
    asm volatile("" ::: "memory");
    const float lt = lsum + __shfl_xor(lsum, 32);
    int tid_e = threadIdx.x; asm volatile("" : "+v"(tid_e));
    const int lane_e = tid_e & 63, h_e = lane_e >> 5, qidx_e = qbase + qg * 32 + (lane_e & 31);
    LAS float* X = (LAS float*)lds + qg * 4096 + lane_e;
    if (c == 1) {
        const float sc = lam / lt;
#pragma unroll
        for (int d = 0; d < 4; ++d)
#pragma unroll
            for (int i = 0; i < 16; ++i) X[(d * 16 + i) * 64] = O[d][i] * sc;
    }
    asm volatile("s_waitcnt lgkmcnt(0)" ::: "memory");
    __builtin_amdgcn_s_barrier();
    asm volatile("" ::: "memory");
    if (c == 0) {
        const float i0 = 1.f / lt;
        float ss = 0.f;
#pragma unroll
        for (int d = 0; d < 4; ++d)
#pragma unroll
            for (int i = 0; i < 16; ++i) { const float o = O[d][i] * i0 - X[(d * 16 + i) * 64]; O[d][i] = o; ss += o * o; }
        ss += __shfl_xor(ss, 32);
        const float rn = rsqrtf(ss * (1.f / 128.f) + EPSN) * post_scale;
        const int qrow = qbase < CTXL ? (MLAT + b * CTXL + qidx_e) : (b * SEQ + qidx_e - CTXL);
        bf16_t* orow = mix + (size_t)qrow * DM + head * 128;
#pragma unroll
        for (int d = 0; d < 4; ++d)
#pragma unroll
            for (int i4 = 0; i4 < 4; ++i4) {
                const int dv = 32 * d + 8 * i4 + 4 * h_e;
                const f32x4 g = *(const f32x4*)(subg + dv);
                u32x2 w; w.x = pkbf(O[d][4 * i4] * rn * g[0], O[d][4 * i4 + 1] * rn * g[1]); w.y = pkbf(O[d][4 * i4 + 2] * rn * g[2], O[d][4 * i4 + 3] * rn * g[3]);
                *(u32x2*)(orow + dv) = w;
            }
    }
    asm volatile("s_waitcnt vmcnt(0) lgkmcnt(0)" ::: "memory");
    __builtin_amdgcn_s_barrier();
    asm volatile("" ::: "memory");
}

template <int W> __device__ __forceinline__ void pool_win(const float* up, int seq0, int L, int tfirst, int ch, LAS float* Pout) {
    constexpr int LO = W / 2, HI = W - W / 2, NV = 31 + W;
    float u[NV];
#pragma unroll
    for (int j = 0; j < NV; ++j) { const int tt = tfirst - LO + j; u[j] = (tt >= 0 && tt < L) ? up[(size_t)(seq0 + tt) * 256 + ch] : 0.f; }
    float c[NV + 1]; c[0] = 0.f;
#pragma unroll
    for (int j = 0; j < NV; ++j) c[j + 1] = c[j] + u[j];
#pragma unroll
    for (int i = 0; i < 32; ++i) {
        const int t = tfirst + i; int lo = t - LO, hi = t + HI; lo = lo < 0 ? 0 : lo; hi = hi > L ? L : hi;
        Pout[i * 256] = (c[i + W] - c[i]) / (float)(hi - lo) - u[i + LO];
    }
}
__device__ __forceinline__ void pool_unit(LAS unsigned char* lds, const float* upool, const float* pw  , const float* pscale, bf16_t* mix, int row0) {
    int tid_l = threadIdx.x; asm volatile("" : "+v"(tid_l)); const int tid = tid_l, lane = tid & 63, wid = __builtin_amdgcn_readfirstlane(tid >> 6);
    LAS float* P = (LAS float*)lds;
    int seq0, L;
    if (row0 < MLAT) { seq0 = row0 & ~(SEQ - 1); L = SEQ; } else { seq0 = MLAT + ((row0 - MLAT) & ~(CTXL - 1)); L = CTXL; }
    {
        const int g = wid & 3, half = wid >> 2, ch = g * 64 + lane, tfirst = row0 - seq0 + half * 32;
        LAS float* Pout = P + (half * 32) * 256 + ch;
        if (g == 0) pool_win<2>(upool, seq0, L, tfirst, ch, Pout);
        else if (g == 1) pool_win<4>(upool, seq0, L, tfirst, ch, Pout);
        else if (g == 2) pool_win<8>(upool, seq0, L, tfirst, ch, Pout);
        else pool_win<16>(upool, seq0, L, tfirst, ch, Pout);
    }
    __syncthreads();
    {
        const int g = wid & 3, half = wid >> 2;
        float wv[64];
#pragma unroll
        for (int c = 0; c < 64; ++c) wv[c] = pw[(size_t)(g * 64 + c) * 64 + lane];
        const float sc = pscale[g * 64 + lane];
#pragma unroll 2
        for (int i = 0; i < 32; ++i) {
            const int tk = half * 32 + i;
            const LAS f32x4* pr = (const LAS f32x4*)(P + tk * 256 + g * 64);
            float a0 = 0.f, a1 = 0.f, a2 = 0.f, a3 = 0.f;
#pragma unroll
            for (int c4 = 0; c4 < 16; ++c4) { const f32x4 p4 = pr[c4]; a0 += p4[0] * wv[4 * c4]; a1 += p4[1] * wv[4 * c4 + 1]; a2 += p4[2] * wv[4 * c4 + 2]; a3 += p4[3] * wv[4 * c4 + 3]; }
            const float y = ((a0 + a1) + (a2 + a3)) * sc;
            const unsigned bits = pkbf(y, 0.f);
            mix[(size_t)(row0 + tk) * DM + 512 + g * 64 + lane] = (bf16_t)(bits & 0xffffu);
        }
    }
    __syncthreads();
}

__device__ __forceinline__ void conv_unit(LAS unsigned char* lds, const float* uconv, const float* cw  , const float* cb, const float* lng, const float* lnb, bf16_t* mix, int row0) {
    int tid_l = threadIdx.x; asm volatile("" : "+v"(tid_l)); const int tid = tid_l, lane = tid & 63, wid = tid >> 6;
    LAS float* Y = (LAS float*)lds;
    int seq0, L;
    if (row0 < MLAT) { seq0 = row0 & ~(SEQ - 1); L = SEQ; } else { seq0 = MLAT + ((row0 - MLAT) & ~(CTXL - 1)); L = CTXL; }
    {
        const int ch = tid & 255, half = tid >> 8;
        float w[31];
#pragma unroll
        for (int j = 0; j < 31; ++j) w[j] = cw[j * 256 + ch];
        const float bias = cb[ch];
        for (int i8 = 0; i8 < 4; ++i8) {
            const int t0 = row0 - seq0 + half * 32 + i8 * 8;
            float uwin[38];
#pragma unroll
            for (int j = 0; j < 38; ++j) { const int tt = t0 - 15 + j; uwin[j] = (tt >= 0 && tt < L) ? uconv[(size_t)(seq0 + tt) * 256 + ch] : 0.f; }
#pragma unroll
            for (int i = 0; i < 8; ++i) {
                float a = bias;
#pragma unroll
                for (int j = 0; j < 31; ++j) a += uwin[i + j] * w[j];
                Y[(half * 32 + i8 * 8 + i) * 256 + ch] = a;
            }
        }
    }
    __syncthreads();
    {
        const f32x4 g4 = *(const f32x4*)(lng + 4 * lane), b4 = *(const f32x4*)(lnb + 4 * lane);
        for (int i = 0; i < 8; ++i) {
            const int tk = wid * 8 + i;
            const f32x4 y = *(const LAS f32x4*)(Y + tk * 256 + 4 * lane);
            const float mu = wave_sum((y[0] + y[1]) + (y[2] + y[3])) * (1.f / 256.f);
            const f32x4 d = y - mu;
            const float var = wave_sum((d[0] * d[0] + d[1] * d[1]) + (d[2] * d[2] + d[3] * d[3])) * (1.f / 256.f);
            const float rs = rsqrtf(var + EPSN);
            f32x4 z = d * rs * g4 + b4;
#pragma unroll
            for (int j = 0; j < 4; ++j) z[j] = z[j] * sigm(z[j]);
            u32x2 w; w.x = pkbf(z[0], z[1]); w.y = pkbf(z[2], z[3]);
            *(u32x2*)(mix + (size_t)(row0 + tk) * DM + 768 + 4 * lane) = w;
        }
    }
    __syncthreads();
}

__device__ __forceinline__ void ctx_slice_gemm(LAS unsigned char* lds, const bf16_t* A  , const bf16_t* Bt  , int K,
                                               const float* res_ctx, float* dst_ctx, const float* gate2  , const float* ng, const float* nsc2  ,
                                               bf16_t* xg, float* rowsq_next, int blk) {
    int tid_l = threadIdx.x; asm volatile("" : "+v"(tid_l)); const int tid = tid_l, lane = tid & 63, wid = __builtin_amdgcn_readfirstlane(tid >> 6), r = lane & 31, h = lane >> 5;
    const int row0 = (blk >> 5) * 64, col0 = (blk & 31) * 32;
    const int kw = K >> 3, kbeg = wid * kw;
    const bf16_t* a0 = A + (size_t)(MLAT + row0 + r) * K + kbeg + 8 * h;
    const bf16_t* a1 = a0 + (size_t)32 * K;
    const bf16_t* bp = Bt + (size_t)(col0 + r) * K + kbeg + 8 * h;
    f32x16 acc0, acc1;
#pragma unroll
    for (int i = 0; i < 16; ++i) { acc0[i] = 0.f; acc1[i] = 0.f; }
#pragma unroll 4
    for (int k = 0; k < kw; k += 32) {
        const bf16x8 fa0 = *(const bf16x8*)(a0 + k), fa1 = *(const bf16x8*)(a1 + k), fb = *(const bf16x8*)(bp + k);
        const bf16x8 ga0 = *(const bf16x8*)(a0 + k + 16), ga1 = *(const bf16x8*)(a1 + k + 16), gb = *(const bf16x8*)(bp + k + 16);
        acc0 = __builtin_amdgcn_mfma_f32_32x32x16_bf16(fa0, fb, acc0, 0, 0, 0);
        acc1 = __builtin_amdgcn_mfma_f32_32x32x16_bf16(fa1, fb, acc1, 0, 0, 0);
        acc0 = __builtin_amdgcn_mfma_f32_32x32x16_bf16(ga0, gb, acc0, 0, 0, 0);
        acc1 = __builtin_amdgcn_mfma_f32_32x32x16_bf16(ga1, gb, acc1, 0, 0, 0);
    }
    LAS float* part = (LAS float*)lds;
#pragma unroll
    for (int i = 0; i < 16; ++i) { part[((wid * 2 + 0) * 16 + i) * 64 + lane] = acc0[i]; part[((wid * 2 + 1) * 16 + i) * 64 + lane] = acc1[i]; }
    __syncthreads();
    {
        const int sub = wid, g = sub >> 2, q4 = sub & 3, col = col0 + r;
        const float gt = gate2[col];
        const bool nxt = ng != nullptr;
        const float gs = nxt ? ng[col] * (1.f + nsc2[col]) : 0.f;
#pragma unroll
        for (int j = 0; j < 4; ++j) {
            const int i = q4 * 4 + j;
            float s = 0.f;
#pragma unroll
            for (int w = 0; w < 8; ++w) s += part[((w * 2 + g) * 16 + i) * 64 + lane];
            const int rr = row0 + 32 * g + 8 * q4 + 4 * h + j;
            const float x = res_ctx[(size_t)rr * DM + col] + gt * s;
            dst_ctx[(size_t)rr * DM + col] = x;
            if (nxt) {
                xg[(size_t)(MLAT + rr) * DM + col] = (bf16_t)(pkbf(x * gs, 0.f) & 0xffffu);
                float ss = x * x;
                ss += __shfl_xor(ss, 1); ss += __shfl_xor(ss, 2); ss += __shfl_xor(ss, 4); ss += __shfl_xor(ss, 8); ss += __shfl_xor(ss, 16);
                if (r == 0) unsafeAtomicAdd(rowsq_next + MLAT + rr, ss);
            }
        }
    }
    __syncthreads();
}

__device__ __forceinline__ void transpose_item(const float* W, int K, int N, bf16_t* WT, int k0, int n_src, int n_dst, LAS float* scr, int lane) {
#pragma unroll 8
    for (int i = 0; i < 32; ++i) { const int kk = 2 * i + (lane >> 5); scr[kk * 33 + (lane & 31)] = W[(size_t)(k0 + kk) * N + n_src + (lane & 31)]; }
    asm volatile("s_waitcnt lgkmcnt(0)" ::: "memory");
    const int c = lane & 7;
#pragma unroll
    for (int j = 0; j < 4; ++j) {
        const int n = (lane >> 3) + 8 * j; const LAS float* s = scr + (8 * c) * 33 + n;
        u32x4 o; o.x = pkbf(s[0 * 33], s[1 * 33]); o.y = pkbf(s[2 * 33], s[3 * 33]); o.z = pkbf(s[4 * 33], s[5 * 33]); o.w = pkbf(s[6 * 33], s[7 * 33]);
        *(u32x4*)(WT + (size_t)(n_dst + n) * K + k0 + 8 * c) = o;
    }
    asm volatile("s_waitcnt lgkmcnt(0)" ::: "memory");
}

__device__ __forceinline__ void convert_layer(const Params& p, LAS unsigned char* lds, int l, int gwi, int ngw, int lane, int wid) {
    LAS float* scr = (LAS float*)(lds + wid * 16384);
    unsigned char* wl = p.ws + WS_W + (size_t)l * W_LAYER;
    for (int it = gwi; it < 5888; it += ngw) {
        int rr = it;
        if (rr < 1152) { const int kb = rr / 72, nb = rr % 72; transpose_item(p.w_in + (size_t)l * DM * INW, DM, INW, (bf16_t*)(wl + W_IN), 64 * kb, perm_in(32 * nb), 32 * nb, scr, lane); continue; } rr -= 1152;
        if (rr < 512) { const int kb = rr / 32, nb = rr % 32; transpose_item(p.w_out + (size_t)l * DM * DM, DM, DM, (bf16_t*)(wl + W_OUT), 64 * kb, 32 * nb, 32 * nb, scr, lane); continue; } rr -= 512;
        if (rr < 2816) { const int kb = rr / 176, nb = rr % 176; transpose_item(p.w_ffn_in + (size_t)l * DM * FFI, DM, FFI, (bf16_t*)(wl + W_FI), 64 * kb, perm_fi(32 * nb), 32 * nb, scr, lane); continue; } rr -= 2816;
        { const int kb = rr / 32, nb = rr % 32; transpose_item(p.w_ffn_out + (size_t)l * FFH * DM, FFH, DM, (bf16_t*)(wl + W_FO), 64 * kb, 32 * nb, 32 * nb, scr, lane); }
    }
}
__device__ __forceinline__ void bias_rows(const bf16_t* Wt, int N, const float* sh  , float* bias  , int gwi, int ngw, int lane) {
    f32x4 s[3][4];
#pragma unroll
    for (int v = 0; v < 3; ++v)
#pragma unroll
        for (int j = 0; j < 4; ++j) s[v][j] = *(const f32x4*)(sh + v * 6144 + (j >> 1) * 512 + 8 * lane + 4 * (j & 1));
    for (int n = gwi; n < N; n += ngw) {
        const u32x4 w0 = *(const u32x4*)(Wt + (size_t)n * DM + 8 * lane), w1 = *(const u32x4*)(Wt + (size_t)n * DM + 512 + 8 * lane);
        float wf[16];
#pragma unroll
        for (int j = 0; j < 4; ++j) { wf[2 * j] = __uint_as_float(w0[j] << 16); wf[2 * j + 1] = __uint_as_float(w0[j] & 0xffff0000u); wf[8 + 2 * j] = __uint_as_float(w1[j] << 16); wf[8 + 2 * j + 1] = __uint_as_float(w1[j] & 0xffff0000u); }
#pragma unroll
        for (int v = 0; v < 3; ++v) {
            float a = 0.f;
#pragma unroll
            for (int j = 0; j < 16; ++j) a += wf[j] * s[v][j >> 2][j & 3];
            a = wave_sum(a);
            if (lane == 0) bias[(size_t)v * N + n] = a;
        }
    }
}
__device__ __forceinline__ void bias_layer(const Params& p, int l, int gwi, int ngw, int lane) {
    unsigned char* ws = p.ws;
    const float* modl = (const float*)(ws + Z_MOD) + (size_t)(l * 3) * 6144;
    const unsigned char* wl = ws + WS_W + (size_t)l * W_LAYER;
    bias_rows((const bf16_t*)(wl + W_IN), INW, modl, (float*)(ws + Z_BIAS1) + (size_t)(l * 3) * INW, gwi, ngw, lane);
    bias_rows((const bf16_t*)(wl + W_FI), FFI, modl + 3 * DM, (float*)(ws + Z_BIAS2) + (size_t)(l * 3) * FFI, gwi, ngw, lane);
}
__device__ __forceinline__ void phase_p0a(const Params& p, LAS unsigned char* lds) {
    int tid_l = threadIdx.x; asm volatile("" : "+v"(tid_l)); const int tid = tid_l, lane = tid & 63, wid = tid >> 6;
    const int G = gridDim.x, gw = blockIdx.x * 8 + wid, NGW = G * 8;
    unsigned char* ws = p.ws;
    float* MOD = (float*)(ws + Z_MOD);
    {
        const int gt = blockIdx.x * 512 + tid;
        if (gt < 2048) { const int pos = gt >> 4, fi = gt & 15; const float inv = powf(10000.f, -(float)fi * (1.f / 16.f)); const float ang = (float)pos * inv;
            float* rp = (float*)(ws + WS_ROPE); rp[2 * gt] = cosf(ang); rp[2 * gt + 1] = sinf(ang); }
        if (gt >= 2048 && gt < 2048 + DEPTH) { const int l = gt - 2048; float s1 = 0.f, s2 = 0.f;
            for (int i = 0; i < 64; ++i) { s1 += p.lq1[l * 64 + i] * p.lk1[l * 64 + i]; s2 += p.lq2[l * 64 + i] * p.lk2[l * 64 + i]; }
            const float li = 0.8f - 0.6f * expf(-0.3f * (float)l);
            ((float*)(ws + WS_LAM))[l] = expf(s1) - expf(s2) + li; }
    }
    for (int it = gw; it < DEPTH * 24 * 16; it += NGW) {
        const int l = it / 384, rem = it % 384, cgp = rem >> 4, kc = rem & 15, col = cgp * 256 + 4 * lane, k0 = kc * 64;
        f32x4 a0 = {0.f, 0.f, 0.f, 0.f}, a1 = a0, a2 = a0;
        const float* W = p.w_mod + ((size_t)l * DM + k0) * 6144 + col;
#pragma unroll 8
        for (int kk = 0; kk < 64; ++kk) {
            const f32x4 w = *(const f32x4*)(W + (size_t)kk * 6144);
            const float s0 = siluf(p.c[k0 + kk]), s1 = siluf(p.c[DM + k0 + kk]), s2 = siluf(p.c_ctx[k0 + kk]);
            a0 += w * s0; a1 += w * s1; a2 += w * s2;
        }
        if (kc == 0) { const f32x4 bm = *(const f32x4*)(p.b_mod + l * 6144 + col); a0 += bm; a1 += bm; a2 += bm; }
        float* d0 = MOD + (size_t)(l * 3) * 6144 + col;
#pragma unroll
        for (int j = 0; j < 4; ++j) { unsafeAtomicAdd(d0 + j, a0[j]); unsafeAtomicAdd(d0 + 6144 + j, a1[j]); unsafeAtomicAdd(d0 + 2 * 6144 + j, a2[j]); }
    }
    for (int l = 0; l < DEPTH; ++l) convert_layer(p, lds, l, gw, NGW, lane, wid);
}

__device__ __forceinline__ void phase_p0b(const Params& p) {
    int tid_l = threadIdx.x; asm volatile("" : "+v"(tid_l)); const int tid = tid_l, lane = tid & 63, wid = tid >> 6;
    const int G = gridDim.x, gw = blockIdx.x * 8 + wid, NGW = G * 8;
    unsigned char* ws = p.ws;
    const float* MOD = (const float*)(ws + Z_MOD);
    bias_layer(p, 0, gw, NGW, lane);
    bf16_t* XG = (bf16_t*)(ws + WS_XG);
    float* rs = (float*)(ws + Z_ROWSQ);
    for (int row0 = gw; row0 < MALL; row0 += 2 * NGW) {
        const int rows[2] = {row0, row0 + NGW};
        f32x4 xv[2][4]; int vv[2];
#pragma unroll
        for (int q = 0; q < 2; ++q) {
            const int row = rows[q] < MALL ? rows[q] : row0;
            const float* src;
            if (row < MLAT) { src = p.x + (size_t)row * DM; vv[q] = row >> 13; } else { src = p.ctx + (size_t)(row - MLAT) * DM; vv[q] = 2; }
#pragma unroll
            for (int j = 0; j < 4; ++j) xv[q][j] = *(const f32x4*)(src + 4 * lane + 256 * j);
        }
#pragma unroll
        for (int q = 0; q < 2; ++q) {
            if (rows[q] >= MALL) continue;
            const int row = rows[q];
            const float* sc = MOD + (size_t)vv[q] * 6144 + DM;
            float ss = 0.f;
#pragma unroll
            for (int j = 0; j < 4; ++j) {
                const int col = 4 * lane + 256 * j;
                const f32x4 x4 = xv[q][j], g = *(const f32x4*)(p.norm1_g + col), s = *(const f32x4*)(sc + col);
                ss += (x4[0] * x4[0] + x4[1] * x4[1]) + (x4[2] * x4[2] + x4[3] * x4[3]);
                const f32x4 y = x4 * g * (s + 1.f);
                u32x2 w; w.x = pkbf(y[0], y[1]); w.y = pkbf(y[2], y[3]);
                *(u32x2*)(XG + (size_t)row * DM + col) = w;
            }
            ss = wave_sum(ss);
            if (lane == 0) rs[row] = ss;
        }
    }
}

constexpr int IPA_QKV = 66 * 6, IPA_N = 512, IPB_N = 66 * 9 - IPA_N;
__device__ __forceinline__ void ip_tail_tile(int a2, Unit& u) { u.pm = a2 / 3; u.pn = 6 + a2 % 3; }
struct InProjOrderA {
    int G, c;
    __device__ bool next(int i, Unit& u) const {
        const int L = i * G + c; if (L >= IPA_N) return false;
        const int a = (L % pg8::NXCD) * (IPA_N / pg8::NXCD) + L / pg8::NXCD;
        if (a < IPA_QKV) { const int gid = a / 48, fm = gid * 8, gsz = (66 - fm) < 8 ? (66 - fm) : 8, w = a % 48; u.pm = fm + w % gsz; u.pn = w / gsz; }
        else ip_tail_tile(a - IPA_QKV, u);
        return true;
    }
    __device__ __forceinline__ void a_ready(const Unit&) const {}
    __device__ __forceinline__ void done(const Unit&) const {}
};
struct InProjOrderB {
    int G, c;
    __device__ bool next(int i, Unit& u) const { const int L = i * G + c; if (L >= IPB_N) return false; ip_tail_tile(IPA_N - IPA_QKV + L, u); return true; }
    __device__ __forceinline__ void a_ready(const Unit&) const {}
    __device__ __forceinline__ void done(const Unit&) const {}
};

__global__ void __launch_bounds__(512, 2) fwd_megakernel(Params p) {
    extern __shared__ __attribute__((aligned(16))) unsigned char lds_raw[];
    LAS unsigned char* lds = (LAS unsigned char*)lds_raw;
    cg::grid_group grid = cg::this_grid();
    const int G = gridDim.x, bx = blockIdx.x;
#define PH_WS() unsigned char* ws = p.ws; asm volatile("" : "+s"(ws))
#define MOD ((const float*)(ws + Z_MOD))
#define ROWSQ ((float*)(ws + Z_ROWSQ))
#define XG ((bf16_t*)(ws + WS_XG))
#define QB ((bf16_t*)(ws + WS_Q))
#define KB ((bf16_t*)(ws + WS_K))
#define VB ((bf16_t*)(ws + WS_V))
#define UP ((float*)(ws + WS_UP))
#define UC ((float*)(ws + WS_UC))
#define MIX ((bf16_t*)(ws + WS_MIX))
#define ACT ((bf16_t*)(ws + WS_ACT))
#define XC ((float*)(ws + WS_XC))
#define wl (ws + WS_W + (size_t)l * W_LAYER)
#define modl (MOD + (size_t)(l * 3) * 6144)
#define rs1 (ROWSQ + (size_t)(2 * l) * MALL)
#define rs2 (ROWSQ + (size_t)(2 * l + 1) * MALL)

    volatile LAS unsigned* bst = (volatile LAS unsigned*)(lds + 131072 + 64);
    if (threadIdx.x < 2) bst[threadIdx.x] = 0u;
    __syncthreads();
    { PH_WS(); (void)xcd_barrier_post((unsigned*)(ws + Z_BAR), bst); }
#define GRID_BAR() do { XcdBarrier xb2_; unsigned* barp_ = (unsigned*)(p.ws + Z_BAR); asm volatile("" : "+s"(barp_)); xb2_.bar = barp_; xb2_.x = xb_xcc_id(); xb2_.st = bst; xcd_barrier(xb2_); } while (0)

    phase_p0a(p, lds);
    grid.sync();
    phase_p0b(p);
    GRID_BAR();

#pragma nounroll
    for (int l = 0; l < DEPTH; ++l) {
        const bool last = l == DEPTH - 1;
        {
            PH_WS();
            pg8::Gemm g{XG, (const bf16_t*)(wl + W_IN), MALL, INW, DM}; const InProjOrderA S{G, bx};
            EpiInProj E{rs1, (const float*)(ws + Z_BIAS1) + (size_t)(l * 3) * INW, p.q_norm_g + l * 64, p.k_norm_g + l * 64, (const float*)(ws + WS_ROPE), QB, KB, VB, UP, UC};
            pg8::gemm_phase<EpiInProj, InProjOrderA, true, true>(lds, g, S, E);
        }
        GRID_BAR();
        {
            PH_WS();
            unsigned* cntw = (unsigned*)(ws + Z_CNT) + 64 * l;
            const int nlate = IPB_N < G ? IPB_N : 0;
            if (bx < IPB_N) {
                pg8::Gemm g{XG, (const bf16_t*)(wl + W_IN), MALL, INW, DM}; const InProjOrderB S{G, bx};
                EpiInProj E{rs1, (const float*)(ws + Z_BIAS1) + (size_t)(l * 3) * INW, p.q_norm_g + l * 64, p.k_norm_g + l * 64, (const float*)(ws + WS_ROPE), QB, KB, VB, UP, UC};
                pg8::gemm_phase<EpiInProj, InProjOrderB, true, true>(lds, g, S, E);
                asm volatile("s_waitcnt vmcnt(0)" ::: "memory");
                __syncthreads();
                if (threadIdx.x == 0) {
                    int ntile = 0; for (int i = 0; i * G + bx < IPB_N; ++i) ++ntile;
                    __builtin_amdgcn_fence(__ATOMIC_RELEASE, "agent"); asm volatile("s_waitcnt vmcnt(0)" ::: "memory");
                    __hip_atomic_fetch_add(cntw, (unsigned)ntile, __ATOMIC_RELAXED, __HIP_MEMORY_SCOPE_AGENT);
                }
            }
            const float lam = ((const float*)(ws + WS_LAM))[l];
            const float post = 1.f - (0.8f - 0.6f * expf(-0.3f * (float)l));
            for (int u = bx; u < 512; u += G) attn_unit(lds, QB, KB, VB, MIX, (u & 7) >> 2, u & 3, CTXL + (u >> 3) * 128, lam, post, p.subln_g + l * 128);
            const int nrt = (last ? MLAT : MALL) / 64;
            const int nca = last ? 0 : 16;
            const int NE = nca + 2 * nrt;
            const bool part = bx >= nlate;
            if (part) {
                if (threadIdx.x == 0) {
                    unsigned sp = 0;
                    while (__hip_atomic_load(cntw, __ATOMIC_RELAXED, __HIP_MEMORY_SCOPE_AGENT) < (unsigned)IPB_N) { __builtin_amdgcn_s_sleep(2); if (++sp > (1u << 22)) break; }
                    __builtin_amdgcn_fence(__ATOMIC_ACQUIRE, "agent"); asm volatile("s_waitcnt vmcnt(0)" ::: "memory");
                }
                __syncthreads();
            }
            for (int e = bx - nlate; part && e < NE; e += G - nlate) {
                if (e < nca) attn_unit(lds, QB, KB, VB, MIX, e >> 3, (e >> 1) & 3, (e & 1) * 128, lam, post, p.subln_g + l * 128);
                else if (e < nca + nrt) conv_unit(lds, UC, p.conv_w + (size_t)l * 31 * 256, p.conv_b + l * 256, p.conv_ln_g + l * 256, p.conv_ln_b + l * 256, MIX, (e - nca) * 64);
                else pool_unit(lds, UP, p.pool_w + (size_t)l * 4 * 64 * 64, p.pool_scale + l * 256, MIX, (e - nca - nrt) * 64);
            }
        }
        GRID_BAR();
        const int Mrows = last ? MLAT : MALL;
        {
            PH_WS();
            pg8::Gemm g{MIX, (const bf16_t*)(wl + W_OUT), MLAT, DM, DM}; pg8::StaticOrder S; S.init(MLAT, DM, G, bx);
            EpiResid E{l == 0 ? p.x : p.out, l == 0 ? p.ctx : XC, p.out, XC, modl + 2 * DM, p.norm2_g + l * DM, modl + 4 * DM, XG, rs2};
            pg8::gemm_phase<EpiResid, pg8::StaticOrder, true, true>(lds, g, S, E);
            if (!last) for (int blk = bx; blk < 256; blk += G)
                ctx_slice_gemm(lds, MIX, (const bf16_t*)(wl + W_OUT), DM, l == 0 ? p.ctx : XC, XC, modl + 2 * 6144 + 2 * DM, p.norm2_g + l * DM, modl + 2 * 6144 + 4 * DM, XG, rs2, blk);
        }
        GRID_BAR();
        {
            PH_WS();
            pg8::Gemm g{XG, (const bf16_t*)(wl + W_FI), Mrows, FFI, DM}; pg8::StaticOrder S; S.init(Mrows, FFI, G, bx);
            EpiSwiGLU E{rs2, (const float*)(ws + Z_BIAS2) + (size_t)(l * 3) * FFI, ACT};
            pg8::gemm_phase<EpiSwiGLU, pg8::StaticOrder, true, true>(lds, g, S, E);
            if (!last) {
                const int nwg = (Mrows / 256) * (FFI / 256), rounds = (nwg + G - 1) / G; int nbusy = nwg - (rounds - 1) * G; if (nbusy >= G) nbusy = 0;
                if (bx >= nbusy) { int t_l = threadIdx.x; asm volatile("" : "+v"(t_l)); bias_layer(p, l + 1, (bx - nbusy) * 8 + (t_l >> 6), (G - nbusy) * 8, t_l & 63); }
            }
        }
        GRID_BAR();
        {
            PH_WS();
            pg8::Gemm g{ACT, (const bf16_t*)(wl + W_FO), MLAT, DM, FFH}; pg8::StaticOrder S; S.init(MLAT, DM, G, bx);
            EpiResid E{p.out, XC, p.out, XC, modl + 5 * DM, last ? nullptr : p.norm1_g + (l + 1) * DM, modl + 3 * 6144 + 1 * DM, XG, ROWSQ + (size_t)(2 * (l + 1)) * MALL};
            pg8::gemm_phase<EpiResid, pg8::StaticOrder, true, true>(lds, g, S, E);
            if (!last) for (int blk = bx; blk < 256; blk += G)
                ctx_slice_gemm(lds, ACT, (const bf16_t*)(wl + W_FO), FFH, XC, XC, modl + 2 * 6144 + 5 * DM, p.norm1_g + (l + 1) * DM, modl + 3 * 6144 + 2 * 6144 + 1 * DM, XG, ROWSQ + (size_t)(2 * (l + 1)) * MALL, blk);
        }
        if (!last) GRID_BAR();
    }
}
#undef MOD
#undef ROWSQ
#undef XG
#undef QB
#undef KB
#undef VB
#undef UP
#undef UC
#undef MIX
#undef ACT
#undef XC
#undef wl
#undef modl
#undef rs1
#undef rs2

extern "C" void kernel_launch(void* const* d_in, const int* in_sizes, int n_in, void* d_out, int out_size, void* d_ws, size_t ws_size, hipStream_t stream) {
    static int grid = 0;
    if (grid == 0) {
        if (n_in != 25 || out_size != MLAT * DM || ws_size < WS_END) { fprintf(stderr, "kernel_launch: unexpected shapes (n_in %d out %d ws %zu)\n", n_in, out_size, ws_size); grid = -1; return; }
        int dev = 0, cus = 0, per_cu = 0;
        hipGetDevice(&dev);
        hipDeviceGetAttribute(&cus, hipDeviceAttributeMultiprocessorCount, dev);
        hipFuncSetAttribute((const void*)fwd_megakernel, hipFuncAttributeMaxDynamicSharedMemorySize, LDS_BYTES);
        hipOccupancyMaxActiveBlocksPerMultiprocessor(&per_cu, (const void*)fwd_megakernel, 512, LDS_BYTES);
        if (per_cu < 1 || cus < 1) { fprintf(stderr, "kernel_launch: occupancy query %d x %d\n", per_cu, cus); grid = -1; return; }
        grid = cus;
        (void)hipGetLastError();
    }
    if (grid < 0) return;
    hipMemsetAsync(d_ws, 0, ZERO_BYTES, stream);
    Params p{};
    const float** pp = (const float**)&p;
    for (int i = 0; i < 25; ++i) pp[i] = (const float*)d_in[i];
    p.out = (float*)d_out; p.ws = (unsigned char*)d_ws;
    void* args[] = {&p};
    hipError_t e = hipLaunchCooperativeKernel((const void*)fwd_megakernel, dim3(grid), dim3(512), args, LDS_BYTES, stream);
    if (e != hipSuccess) fprintf(stderr, "cooperative launch failed: %s (grid %d)\n", hipGetErrorString(e), grid);
}
```

```cpp
#include <hip/hip_runtime.h>
#include <hip/hip_cooperative_groups.h>
#include <cstdio>
#include <cstdint>
namespace cg = cooperative_groups;
namespace pg8 {
#define PG8_LAS __attribute__((address_space(3)))
typedef unsigned short bf16_t;
typedef short bf16x8 __attribute__((ext_vector_type(8)));
typedef float f32x4 __attribute__((ext_vector_type(4)));
typedef unsigned u32x4 __attribute__((ext_vector_type(4)));
constexpr int BM = 256, BK = 64, HALF = 128, HTB = HALF * BK * 2  , STAGE_BYTES = 8 * HTB, NXCD = 8, WGM = 8;

__host__ __device__ __forceinline__ int lds_byte(int r, int c) { const int st = (r >> 4) * 2 + (c >> 5), rr = r & 15, cc = c & 31, ob = rr * 64 + cc * 2; return st * 1024 + (ob ^ (((ob >> 9) & 1) << 5)); }
__host__ __device__ __forceinline__ void stage_rc(int b, int& R, int& C) { const int st = b / 1024, sb = b % 1024, swz = sb ^ (((sb >> 9) & 1) << 5); R = (st >> 1) * 16 + swz / 64; C = (st & 1) * 32 + (swz % 64) / 2; }
__host__ __device__ __forceinline__ int perm32(int rho) { const int n = rho >> 4, i = rho & 15; return 8 * (i >> 2) + 4 * n + (i & 3); }

struct Unit { int pm, pn; };
struct Gemm { const bf16_t* A; const bf16_t* Bt; int M, N, K; };

struct StaticOrder {
    int nM, nN, nwg, G, c;
    __host__ __device__ void init(int M, int N, int G_, int c_) { nM = M / BM; nN = N / BM; nwg = nM * nN; G = G_; c = c_; }
    __host__ __device__ bool next(int i, Unit& u) const {
        const long L = (long)i * G + c; if (L >= nwg) return false;
        int wgid = (int)L; { const int q = nwg / NXCD, r = nwg % NXCD, xcd = wgid % NXCD, off = wgid / NXCD; wgid = (xcd < r ? xcd * (q + 1) : r * (q + 1) + (xcd - r) * q) + off; }
        const int nig = WGM * nN, gid = wgid / nig, fm = gid * WGM, gsz = (nM - fm) < WGM ? (nM - fm) : WGM;
        u.pm = fm + ((wgid % nig) % gsz); u.pn = (wgid % nig) / gsz; return true;
    }
    __device__ __forceinline__ void a_ready(const Unit&) const {}
    __device__ __forceinline__ void done(const Unit&) const {}
};

__device__ __forceinline__ unsigned cvt_pk_bf16(float lo, float hi) { unsigned r; asm volatile("v_cvt_pk_bf16_f32 %0, %1, %2" : "=v"(r) : "v"(lo), "v"(hi)); return r; }
typedef float f32x2 __attribute__((ext_vector_type(2)));
template <class Epi, class Sched, bool ALIGN_EPI = false, bool SP2 = false>
__device__ __forceinline__ void gemm_phase(PG8_LAS unsigned char* lds, const Gemm g, const Sched& S, const Epi& E) {
    int tid_l = threadIdx.x; asm volatile("" : "+v"(tid_l)); const int tid = tid_l, wid = __builtin_amdgcn_readfirstlane(tid >> 6), lane = tid & 63, wr = wid >> 2, wc = wid & 3, fr = lane & 15, fq = lane >> 4;
    const int K = g.K, nt = K / BK;
    unsigned voffA[2], voffB[2];
#pragma unroll
    for (int i = 0; i < 2; ++i) { int R, C; stage_rc(tid * 16 + i * 8192, R, C); const int Rb = Epi::PERM ? ((R & ~31) + perm32(R & 31)) : R;
        voffA[i] = (unsigned)(R * K + C) * 2u; voffB[i] = (unsigned)(Rb * K + C) * 2u; }
    const size_t kstep = (size_t)(BK * 2);
    const size_t hstep = (size_t)HALF * K * 2;
    const size_t tstep = 2 * hstep;
    const unsigned ldsw = (unsigned)wid * 1024u;
    const int aoff = lds_byte(wr * 64 + fr, fq * 8), boff = lds_byte(wc * 32 + fr, fq * 8);
#define PG8_SA(b, h) (((b) * 2 + (h)) * HTB)
#define PG8_SB(b, h) ((4 + (b) * 2 + (h)) * HTB)
#define PG8_STAGE(bufoff, gbase, voff) do { _Pragma("unroll") for (int _i = 0; _i < 2; ++_i) \
        __builtin_amdgcn_global_load_lds((const unsigned*)((const char*)(gbase) + (voff)[_i]), (PG8_LAS unsigned*)(lds + (bufoff) + ldsw + _i * 8192), 16, 0, 0); } while (0)
#define PG8_LDA(dst, b, h) do { _Pragma("unroll") for (int m = 0; m < 4; ++m) _Pragma("unroll") for (int k = 0; k < 2; ++k) dst[m][k] = *(const PG8_LAS bf16x8*)(lds + PG8_SA(b, h) + aoff + m * 2048 + k * 1024); } while (0)
#define PG8_LDB(dst, b, h) do { _Pragma("unroll") for (int n = 0; n < 2; ++n) _Pragma("unroll") for (int k = 0; k < 2; ++k) dst[n][k] = *(const PG8_LAS bf16x8*)(lds + PG8_SB(b, h) + boff + n * 2048 + k * 1024); } while (0)
#define PG8_MMA(ai, bj, At, Bt) do { __builtin_amdgcn_s_setprio(1); _Pragma("unroll") for (int m = 0; m < 4; ++m) _Pragma("unroll") for (int n = 0; n < 2; ++n) _Pragma("unroll") for (int k = 0; k < 2; ++k) \
        acc[ai][bj][m][n] = __builtin_amdgcn_mfma_f32_16x16x32_bf16(Bt[n][k], At[m][k], acc[ai][bj][m][n], 0, 0, 0); __builtin_amdgcn_s_setprio(0); } while (0)
#define PG8_WAIT_V(n) asm volatile("s_waitcnt vmcnt(" #n ")" ::: "memory")
#define PG8_WAIT_L(n) asm volatile("s_waitcnt lgkmcnt(" #n ")" ::: "memory")
#define PG8_BAR __builtin_amdgcn_s_barrier()
#define PG8_SCHED __builtin_amdgcn_sched_barrier(0)
    Unit cur, nxt; int ui = 0;
    if (!S.next(0, cur)) return;
    f32x4 acc[2][2][4][2];
#pragma unroll
    for (int a = 0; a < 2; ++a)
#pragma unroll
        for (int b = 0; b < 2; ++b)
#pragma unroll
            for (int m = 0; m < 4; ++m)
#pragma unroll
                for (int n = 0; n < 2; ++n) acc[a][b][m][n] = (f32x4){0.f, 0.f, 0.f, 0.f};
    bf16x8 At[4][2], B0[2][2], B1[2][2];
    const char* cA = (const char*)g.A + (size_t)cur.pm * tstep; const char* cB = (const char*)g.Bt + (size_t)cur.pn * tstep;
    S.a_ready(cur);
    if constexpr (SP2) {
        PG8_STAGE(PG8_SB(0, 0), cB, voffB); PG8_STAGE(PG8_SB(0, 1), cB + hstep, voffB); PG8_STAGE(PG8_SA(0, 0), cA, voffA); PG8_STAGE(PG8_SA(0, 1), cA + hstep, voffA);
        if (wr == 1) PG8_BAR;
        PG8_WAIT_V(2); PG8_BAR;
        PG8_STAGE(PG8_SB(1, 0), cB + kstep, voffB); PG8_STAGE(PG8_SA(1, 0), cA + kstep, voffA); PG8_STAGE(PG8_SB(1, 1), cB + hstep + kstep, voffB);
        PG8_WAIT_V(6); PG8_BAR;
    } else {
        PG8_STAGE(PG8_SB(0, 0), cB, voffB); PG8_STAGE(PG8_SA(0, 0), cA, voffA); PG8_STAGE(PG8_SB(0, 1), cB + hstep, voffB); PG8_STAGE(PG8_SA(0, 1), cA + hstep, voffA);
        if (wr == 1) PG8_BAR;
        PG8_WAIT_V(4); PG8_BAR;
        PG8_STAGE(PG8_SB(1, 0), cB + kstep, voffB); PG8_STAGE(PG8_SA(1, 0), cA + kstep, voffA); PG8_STAGE(PG8_SB(1, 1), cB + hstep + kstep, voffB);
        PG8_WAIT_V(6); PG8_BAR;
    }
    for (;;) {
        const bool has_next = S.next(ui + 1, nxt);
        const char* nA = has_next ? (const char*)g.A + (size_t)nxt.pm * tstep : cA; const char* nB = has_next ? (const char*)g.Bt + (size_t)nxt.pn * tstep : cB;
        for (int t = 0; t < nt; t += 2) {
            const bool last = (t == nt - 2);
            const char* a1 = cA + (size_t)(t + 1) * kstep;
            const char* a2 = last ? nA : cA + (size_t)(t + 2) * kstep; const char* b2 = last ? nB : cB + (size_t)(t + 2) * kstep;
            const char* a3 = a2 + kstep; const char* b3 = b2 + kstep;
            if (last && has_next) S.a_ready(nxt);
            if constexpr (SP2) {
            PG8_LDB(B0, 0, 0); PG8_LDB(B1, 0, 1); PG8_SCHED; PG8_LDA(At, 0, 0); PG8_STAGE(PG8_SA(1, 1), a1 + hstep, voffA);
            PG8_WAIT_V(8); PG8_WAIT_L(0); PG8_BAR; PG8_MMA(0, 0, At, B0); PG8_MMA(0, 1, At, B1); PG8_BAR; PG8_SCHED;
            PG8_LDA(At, 0, 1); PG8_STAGE(PG8_SB(0, 0), b2, voffB); PG8_STAGE(PG8_SB(0, 1), b2 + hstep, voffB); PG8_STAGE(PG8_SA(0, 0), a2, voffA);
            PG8_WAIT_V(8); PG8_WAIT_L(0); PG8_BAR; PG8_MMA(1, 0, At, B0); PG8_MMA(1, 1, At, B1); PG8_BAR; PG8_SCHED;
            PG8_LDB(B0, 1, 0); PG8_LDB(B1, 1, 1); PG8_SCHED; PG8_LDA(At, 1, 0); PG8_STAGE(PG8_SA(0, 1), a2 + hstep, voffA);
            PG8_WAIT_V(8); PG8_WAIT_L(0); PG8_BAR; PG8_MMA(0, 0, At, B0); PG8_MMA(0, 1, At, B1); PG8_BAR; PG8_SCHED;
            PG8_LDA(At, 1, 1); PG8_STAGE(PG8_SB(1, 0), b3, voffB); PG8_STAGE(PG8_SB(1, 1), b3 + hstep, voffB); PG8_STAGE(PG8_SA(1, 0), a3, voffA);
            PG8_WAIT_V(8); PG8_WAIT_L(0); PG8_BAR; PG8_MMA(1, 0, At, B0); PG8_MMA(1, 1, At, B1); PG8_BAR; PG8_SCHED;
            } else {
            PG8_LDB(B0, 0, 0); PG8_SCHED; PG8_LDA(At, 0, 0); PG8_STAGE(PG8_SA(1, 1), a1 + hstep, voffA);
            PG8_WAIT_L(8); PG8_BAR; PG8_WAIT_L(0); PG8_MMA(0, 0, At, B0); PG8_BAR; PG8_SCHED;
            PG8_LDB(B1, 0, 1); PG8_STAGE(PG8_SB(0, 0), b2, voffB);
            PG8_BAR; PG8_WAIT_L(0); PG8_MMA(0, 1, At, B1); PG8_BAR;
            PG8_LDA(At, 0, 1); PG8_STAGE(PG8_SA(0, 0), a2, voffA);
            PG8_BAR; PG8_WAIT_L(0); PG8_MMA(1, 0, At, B0); PG8_BAR; PG8_SCHED;
            PG8_STAGE(PG8_SB(0, 1), b2 + hstep, voffB);
            PG8_WAIT_V(6); PG8_BAR; PG8_MMA(1, 1, At, B1); PG8_BAR;
            PG8_LDB(B0, 1, 0); PG8_SCHED; PG8_LDA(At, 1, 0); PG8_STAGE(PG8_SA(0, 1), a2 + hstep, voffA);
            PG8_WAIT_L(8); PG8_BAR; PG8_WAIT_L(0); PG8_MMA(0, 0, At, B0); PG8_BAR; PG8_SCHED;
            PG8_LDB(B1, 1, 1); PG8_STAGE(PG8_SB(1, 0), b3, voffB);
            PG8_BAR; PG8_WAIT_L(0); PG8_MMA(0, 1, At, B1); PG8_BAR;
            PG8_LDA(At, 1, 1); PG8_STAGE(PG8_SA(1, 0), a3, voffA);
            PG8_BAR; PG8_WAIT_L(0); PG8_MMA(1, 0, At, B0); PG8_BAR; PG8_SCHED;
            PG8_STAGE(PG8_SB(1, 1), b3 + hstep, voffB);
            PG8_WAIT_V(6); PG8_BAR; PG8_MMA(1, 1, At, B1); PG8_BAR;
            }
        }
        if constexpr (ALIGN_EPI) { if (wr == 0) PG8_BAR; }
        if constexpr (!Epi::AFTER_DRAIN) { E(acc, cur, wr, wc, fr, fq); S.done(cur); }
        if (!has_next) break;
#pragma unroll
        for (int a = 0; a < 2; ++a)
#pragma unroll
            for (int b = 0; b < 2; ++b)
#pragma unroll
                for (int m = 0; m < 4; ++m)
#pragma unroll
                    for (int n = 0; n < 2; ++n) acc[a][b][m][n] = (f32x4){0.f, 0.f, 0.f, 0.f};
        cur = nxt; cA = nA; cB = nB; ++ui;
        if constexpr (ALIGN_EPI) { if (wr == 1) PG8_BAR; }
    }
    PG8_WAIT_V(0);
    if constexpr (!ALIGN_EPI) { if (wr == 0) PG8_BAR; }
    PG8_BAR;
    if constexpr (Epi::AFTER_DRAIN) { E.fused(acc, cur, wr, wc, fr, fq, lds, wid, lane); S.done(cur); }
#undef PG8_SA
#undef PG8_SB
#undef PG8_STAGE
#undef PG8_LDA
#undef PG8_LDB
#undef PG8_MMA
#undef PG8_WAIT_V
#undef PG8_WAIT_L
#undef PG8_BAR
#undef PG8_SCHED
}
}
#define LAS __attribute__((address_space(3)))
#define XB_TMO      128
#define XB_XCNT(j)  (256  + 64 * (j))
#define XB_XSUB(j)  (1280 + 64 * (j))
#define XB_XGEN(j)  (2304 + 64 * (j))
#define XB_TOP      3328
#define XB_TOPGEN   3392
#define XCD_BAR_WORDS 3456
#define XB_SPIN_CAP (1u << 18)

__device__ __forceinline__ unsigned xb_ld(unsigned* p)              { return __hip_atomic_load(p, __ATOMIC_RELAXED, __HIP_MEMORY_SCOPE_AGENT); }
__device__ __forceinline__ unsigned xb_add(unsigned* p, unsigned v) { return __hip_atomic_fetch_add(p, v, __ATOMIC_RELAXED, __HIP_MEMORY_SCOPE_AGENT); }
__device__ __forceinline__ unsigned xb_xcc_id() { return (unsigned)__builtin_amdgcn_s_getreg((3 << 11) | 20) & 0xFu; }
#define XB_SPIN(cond, bar) do { unsigned _sp = 0; while (cond) { __builtin_amdgcn_s_sleep(1); \
    if ((++_sp & 255u) == 0u) { if (xb_ld(&(bar)[XB_TMO])) break; if (_sp > XB_SPIN_CAP) { atomicAdd(&(bar)[XB_TMO], 1u); break; } } } } while (0)

struct XcdBarrier {
    unsigned* bar; unsigned x;
    volatile LAS unsigned* st;
};

__device__ __forceinline__ XcdBarrier xcd_barrier_post(unsigned* bar, volatile LAS unsigned* st) {
    XcdBarrier b; b.bar = bar; b.x = xb_xcc_id(); b.st = st;
    if (threadIdx.x == 0) (void)xb_add(&bar[XB_XCNT(b.x)], 1u);
    return b;
}
__device__ __forceinline__ void xcd_barrier_complete(unsigned* bar, unsigned x, unsigned& nloc, unsigned& nx) {
    const unsigned G = gridDim.x * gridDim.y * gridDim.z;
    unsigned sum, cnt, mine, sp = 0u;
    for (;;) {
        sum = 0u; cnt = 0u; mine = 0u;
#pragma unroll
        for (unsigned j = 0; j < 16; ++j) { const unsigned c = xb_ld(&bar[XB_XCNT(j)]); sum += c; cnt += (c > 0u) ? 1u : 0u; mine = (j == x) ? c : mine; }
        if (sum == G) break;
        __builtin_amdgcn_s_sleep(1);
        if ((++sp & 255u) == 0u) { if (xb_ld(&bar[XB_TMO])) break; if (sp > XB_SPIN_CAP) { atomicAdd(&bar[XB_TMO], 1u); break; } }
    }
    nloc = mine > 0u ? mine : 1u; nx = cnt > 0u ? cnt : 1u;
}

__device__ __forceinline__ void xcd_barrier(const XcdBarrier& b) {
    asm volatile("s_waitcnt vmcnt(0)" ::: "memory");
    __syncthreads();
    if (threadIdx.x == 0) {
        unsigned* bar = b.bar;
        __builtin_amdgcn_s_waitcnt(0);
        unsigned nloc = b.st[0], nx = b.st[1];
        if (nloc == 0u) { xcd_barrier_complete(bar, b.x, nloc, nx); b.st[0] = nloc; b.st[1] = nx; }
        const unsigned old = xb_add(&bar[XB_XSUB(b.x)], 1u);
        const unsigned gen = old / nloc;
        if (old + 1u == (gen + 1u) * nloc) {
            __builtin_amdgcn_fence(__ATOMIC_RELEASE, "agent");
            asm volatile("s_waitcnt vmcnt(0)" ::: "memory");
            const unsigned og = xb_add(&bar[XB_TOP], 1u);
            const unsigned tg = og / nx;
            if (og + 1u == (tg + 1u) * nx) xb_add(&bar[XB_TOPGEN], 1u);
            else XB_SPIN(xb_ld(&bar[XB_TOPGEN]) == tg, bar);
            __builtin_amdgcn_fence(__ATOMIC_ACQUIRE, "agent");
            xb_add(&bar[XB_XGEN(b.x)], 1u);
            asm volatile("s_waitcnt vmcnt(0)" ::: "memory");
        } else {
            XB_SPIN(xb_ld(&bar[XB_XGEN(b.x)]) == gen, bar);
            __builtin_amdgcn_fence(__ATOMIC_ACQUIRE, "agent");
            asm volatile("s_waitcnt vmcnt(0)" ::: "memory");
        }
    }
    __syncthreads();
}

using pg8::bf16_t; using pg8::bf16x8; using pg8::f32x4; using pg8::u32x4; using pg8::Unit;
typedef float f32x16 __attribute__((ext_vector_type(16)));
typedef unsigned u32x2 __attribute__((ext_vector_type(2)));
typedef short s16x4 __attribute__((ext_vector_type(4)));
#define LAS __attribute__((address_space(3)))

constexpr int DM = 1024, NB = 2, SEQ = 8192, DEPTH = 4, CTXL = 256;
constexpr int MLAT = NB * SEQ, MCTX = NB * CTXL, MALL = MLAT + MCTX;
constexpr int INW = 2304, FFH = 2816, FFI = 5632;
constexpr int LK = SEQ + CTXL, NTK = LK / 64;
constexpr float EPSN = 1e-6f;
constexpr float QSCALE = 0.125f * 1.4426950408889634f;

constexpr size_t MiB = 1u << 20;
constexpr size_t ZERO_BYTES = 2 * MiB;
constexpr size_t Z_MOD = 0, Z_BIAS1 = 294912, Z_BIAS2 = 405504, Z_ROWSQ = 675840;
constexpr size_t Z_CNT = 1600000;
constexpr size_t Z_BAR = 1572864;
static_assert(Z_ROWSQ + (size_t)8 * MALL * 4 <= Z_BAR && Z_BAR + XCD_BAR_WORDS * 4 <= Z_CNT && Z_CNT + 4 * 256 <= ZERO_BYTES, "zero region");
constexpr size_t WS_ROPE = 2 * MiB, WS_LAM = 2 * MiB + 16384;
constexpr size_t WS_W = 4 * MiB, W_LAYER = 25 * MiB, W_IN = 0, W_OUT = 4718592, W_FI = 6815744, W_FO = 18350080;
constexpr size_t WS_XG = 104 * MiB, WS_Q = 140 * MiB, WS_K = 157 * MiB, WS_V = 174 * MiB, WS_UP = 191 * MiB, WS_UC = 208 * MiB, WS_MIX = 225 * MiB;
constexpr size_t WS_ACT = 140 * MiB, WS_XC = 259 * MiB, WS_END = 262 * MiB;
constexpr int LDS_BYTES = 147456;

struct Params {
    const float *x, *c, *ctx, *c_ctx, *w_mod, *b_mod, *norm1_g, *w_in, *q_norm_g, *k_norm_g, *lq1, *lk1, *lq2, *lk2, *subln_g, *pool_w, *pool_scale,
                *conv_w, *conv_b, *conv_ln_g, *conv_ln_b, *w_out, *norm2_g, *w_ffn_in, *w_ffn_out;
    float* out; unsigned char* ws;
};

__device__ __forceinline__ float wave_sum(float v) {
#pragma unroll
    for (int o = 1; o < 64; o <<= 1) v += __shfl_xor(v, o);
    return v;
}
__device__ __forceinline__ float sigm(float v) { return __builtin_amdgcn_rcpf(1.f + __builtin_amdgcn_exp2f(-1.4426950408889634f * v)); }
__device__ __forceinline__ float siluf(float v) { return v * sigm(v); }
__device__ __forceinline__ unsigned pkbf(float lo, float hi) { return pg8::cvt_pk_bf16(lo, hi); }

__device__ __forceinline__ int perm_in(int cn) {
    const int pn = cn >> 8, pos = cn & 255;
    if (pn < 4) { const int bj = pos >> 7, wc = (pos >> 5) & 3, e = pos & 31; return pn * 256 + wc * 64 + bj * 32 + e; }
    if (pn < 7) return cn;
    return (pos < 128) ? (1792 + 128 * (pn - 7) + pos) : (2048 + 128 * (pn - 7) + pos - 128);
}
__device__ __forceinline__ int perm_fi(int cn) { const int pn = cn >> 8, pos = cn & 255; return (pos < 128) ? (128 * pn + pos) : (FFH + 128 * pn + pos - 128); }

__device__ __forceinline__ int voff(int row, int ch) { return 2048 * (row >> 3) + 512 * (ch >> 2) + 64 * (row & 7) + 16 * ((ch & 3) ^ ((row >> 2) & 3)); }

struct EpiInProj {
    static constexpr bool PERM = true, AFTER_DRAIN = false;
    const float* rowsq; const float* bias; const float* qg; const float* kg; const float* rope;
    bf16_t* Qb; bf16_t* Kb; bf16_t* Vb; float* upool; float* uconv;
    __device__ __forceinline__ void operator()(const f32x4 (&acc)[2][2][4][2], const Unit& u, int wr, int wc, int fr, int fq) const {
        const int pn = u.pn, pm = u.pm;
        const bool isctx = pm >= 64;
        const int v = isctx ? 2 : (pm >> 5);
        const int cb = pn * 256 + wc * 32 + 8 * fq;
        f32x4 bv[2][2];
#pragma unroll
        for (int bj = 0; bj < 2; ++bj)
#pragma unroll
            for (int n = 0; n < 2; ++n) bv[bj][n] = *(const f32x4*)(bias + v * INW + cb + 128 * bj + 4 * n);
        if (pn < 4) {
            const bool isq = pn < 2;
            const float* gp = isq ? qg : kg;
            f32x4 gv[2][2];
#pragma unroll
            for (int bj = 0; bj < 2; ++bj)
#pragma unroll
                for (int n = 0; n < 2; ++n) gv[bj][n] = *(const f32x4*)(gp + 32 * bj + 8 * fq + 4 * n);
            const int hc = (isq ? pn : pn - 2) * 4 + wc;
            bf16_t* dst = isq ? Qb : Kb;
            const float osc = isq ? QSCALE : 1.f;
#pragma unroll
            for (int ai = 0; ai < 2; ++ai)
#pragma unroll
                for (int m = 0; m < 4; ++m) {
                    const int row = pm * 256 + ai * 128 + wr * 64 + m * 16 + fr;
                    const float rinv = rsqrtf(rowsq[row] * (1.f / DM) + EPSN);
                    int b, kidx, t = 0;
                    if (isctx) { const int rc = row - MLAT; b = rc >> 8; kidx = rc & 255; } else { b = row >> 13; t = row & (SEQ - 1); kidx = CTXL + t; }
                    f32x4 val[2][2]; float ss = 0.f;
#pragma unroll
                    for (int bj = 0; bj < 2; ++bj)
#pragma unroll
                        for (int n = 0; n < 2; ++n) { val[bj][n] = acc[ai][bj][m][n] * rinv + bv[bj][n]; const f32x4 q = val[bj][n]; ss += (q[0] * q[0] + q[1] * q[1]) + (q[2] * q[2] + q[3] * q[3]); }
                    ss += __shfl_xor(ss, 16); ss += __shfl_xor(ss, 32);
                    const float rn = rsqrtf(ss * (1.f / 64.f) + EPSN);
#pragma unroll
                    for (int bj = 0; bj < 2; ++bj) {
                        f32x4 y0 = val[bj][0] * rn * gv[bj][0], y1 = val[bj][1] * rn * gv[bj][1];
                        if (!isctx) {
                            const int pos = bj == 0 ? (t >> 6) : (t & 63);
                            const f32x4 r0 = *(const f32x4*)(rope + (size_t)(pos * 16 + 4 * fq) * 2);
                            const f32x4 r1 = *(const f32x4*)(rope + (size_t)(pos * 16 + 4 * fq + 2) * 2);
                            f32x4 z0, z1;
                            z0[0] = y0[0] * r0[0] - y0[1] * r0[1]; z0[1] = y0[0] * r0[1] + y0[1] * r0[0];
                            z0[2] = y0[2] * r0[2] - y0[3] * r0[3]; z0[3] = y0[2] * r0[3] + y0[3] * r0[2];
                            z1[0] = y1[0] * r1[0] - y1[1] * r1[1]; z1[1] = y1[0] * r1[1] + y1[1] * r1[0];
                            z1[2] = y1[2] * r1[2] - y1[3] * r1[3]; z1[3] = y1[2] * r1[3] + y1[3] * r1[2];
                            y0 = z0; y1 = z1;
                        }
                        y0 = y0 * osc; y1 = y1 * osc;
                        u32x4 w; w.x = pkbf(y0[0], y0[1]); w.y = pkbf(y0[2], y0[3]); w.z = pkbf(y1[0], y1[1]); w.w = pkbf(y1[2], y1[3]);
                        const size_t off = (size_t)(b * 8 + hc) * (LK * 64) + (size_t)(kidx >> 6) * 4096 + (size_t)(4 * bj + fq) * 512 + (size_t)(kidx & 63) * 8;
                        *(u32x4*)(dst + off) = w;
                    }
                }
        } else if (pn < 6) {
#pragma unroll
            for (int ai = 0; ai < 2; ++ai)
#pragma unroll
                for (int m = 0; m < 4; ++m) {
                    const int row = pm * 256 + ai * 128 + wr * 64 + m * 16 + fr;
                    const float rinv = rsqrtf(rowsq[row] * (1.f / DM) + EPSN);
                    int b, kidx;
                    if (isctx) { const int rc = row - MLAT; b = rc >> 8; kidx = rc & 255; } else { b = row >> 13; kidx = CTXL + (row & (SEQ - 1)); }
#pragma unroll
                    for (int bj = 0; bj < 2; ++bj) {
                        const f32x4 y0 = acc[ai][bj][m][0] * rinv + bv[bj][0], y1 = acc[ai][bj][m][1] * rinv + bv[bj][1];
                        u32x4 w; w.x = pkbf(y0[0], y0[1]); w.y = pkbf(y0[2], y0[3]); w.z = pkbf(y1[0], y1[1]); w.w = pkbf(y1[2], y1[3]);
                        const int head = 2 * (pn - 4) + bj;
                        const size_t off = (size_t)(b * 4 + head) * (LK * 128) + (size_t)(kidx >> 6) * 8192 + (size_t)(voff(kidx & 63, 4 * wc + fq) >> 1);
                        *(u32x4*)(Vb + off) = w;
                    }
                }
        } else if (pn == 6) {
#pragma unroll
            for (int ai = 0; ai < 2; ++ai)
#pragma unroll
                for (int m = 0; m < 4; ++m) {
                    const int row = pm * 256 + ai * 128 + wr * 64 + m * 16 + fr;
                    const float rinv = rsqrtf(rowsq[row] * (1.f / DM) + EPSN);
#pragma unroll
                    for (int bj = 0; bj < 2; ++bj)
#pragma unroll
                        for (int n = 0; n < 2; ++n) *(f32x4*)(upool + (size_t)row * 256 + 128 * bj + 32 * wc + 8 * fq + 4 * n) = acc[ai][bj][m][n] * rinv + bv[bj][n];
                }
        } else {
            const int ch0 = 128 * (pn - 7) + 32 * wc + 8 * fq;
#pragma unroll
            for (int ai = 0; ai < 2; ++ai)
#pragma unroll
                for (int m = 0; m < 4; ++m) {
                    const int row = pm * 256 + ai * 128 + wr * 64 + m * 16 + fr;
                    const float rinv = rsqrtf(rowsq[row] * (1.f / DM) + EPSN);
#pragma unroll
                    for (int n = 0; n < 2; ++n) {
                        const f32x4 a = acc[ai][0][m][n] * rinv + bv[0][n], g = acc[ai][1][m][n] * rinv + bv[1][n];
                        f32x4 o;
#pragma unroll
                        for (int j = 0; j < 4; ++j) o[j] = a[j] * sigm(g[j]);
                        *(f32x4*)(uconv + (size_t)row * 256 + ch0 + 4 * n) = o;
                    }
                }
        }
    }
};

struct EpiResid {
    static constexpr bool PERM = true, AFTER_DRAIN = false;
    const float* res_lat; const float* res_ctx; float* dst_lat; float* dst_ctx;
    const float* gate;
    const float* ng;
    const float* nsc;
    bf16_t* xg; float* rowsq_next;
    __device__ __forceinline__ void operator()(const f32x4 (&acc)[2][2][4][2], const Unit& u, int wr, int wc, int fr, int fq) const {
        const int pn = u.pn, pm = u.pm;
        const bool isctx = pm >= 64;
        const int v = isctx ? 2 : (pm >> 5);
        const int cb = pn * 256 + wc * 32 + 8 * fq;
        const bool nxt = ng != nullptr;
        f32x4 gt[2][2], gs[2][2];
#pragma unroll
        for (int bj = 0; bj < 2; ++bj)
#pragma unroll
            for (int n = 0; n < 2; ++n) {
                const int col = cb + 128 * bj + 4 * n;
                gt[bj][n] = *(const f32x4*)(gate + v * 6144 + col);
                if (nxt) { const f32x4 a = *(const f32x4*)(ng + col), s = *(const f32x4*)(nsc + v * 6144 + col); gs[bj][n] = a * (s + 1.f); } else gs[bj][n] = (f32x4){0.f, 0.f, 0.f, 0.f};
            }
#pragma unroll
        for (int q2 = 0; q2 < 4; ++q2) {
            const int ai = q2 >> 1, m0 = (q2 & 1) * 2;
            f32x4 pre[2][2][2];
#pragma unroll
            for (int mm = 0; mm < 2; ++mm) {
                const int row = pm * 256 + ai * 128 + wr * 64 + (m0 + mm) * 16 + fr;
                const float* src = isctx ? res_ctx + (size_t)(row - MLAT) * DM : res_lat + (size_t)row * DM;
#pragma unroll
                for (int bj = 0; bj < 2; ++bj) { pre[mm][bj][0] = *(const f32x4*)(src + cb + 128 * bj); pre[mm][bj][1] = *(const f32x4*)(src + cb + 128 * bj + 4); }
            }
#pragma unroll
            for (int mm = 0; mm < 2; ++mm) {
                const int m = m0 + mm;
                const int row = pm * 256 + ai * 128 + wr * 64 + m * 16 + fr;
                float* dst = isctx ? dst_ctx + (size_t)(row - MLAT) * DM : dst_lat + (size_t)row * DM;
                float ss = 0.f;
#pragma unroll
                for (int bj = 0; bj < 2; ++bj) {
                    const int col = cb + 128 * bj;
                    const f32x4 x0 = pre[mm][bj][0] + gt[bj][0] * acc[ai][bj][m][0];
                    const f32x4 x1 = pre[mm][bj][1] + gt[bj][1] * acc[ai][bj][m][1];
                    *(f32x4*)(dst + col) = x0; *(f32x4*)(dst + col + 4) = x1;
                    if (nxt) {
                        ss += (x0[0] * x0[0] + x0[1] * x0[1]) + (x0[2] * x0[2] + x0[3] * x0[3]) + (x1[0] * x1[0] + x1[1] * x1[1]) + (x1[2] * x1[2] + x1[3] * x1[3]);
                        const f32x4 y0 = x0 * gs[bj][0], y1 = x1 * gs[bj][1];
                        u32x4 w; w.x = pkbf(y0[0], y0[1]); w.y = pkbf(y0[2], y0[3]); w.z = pkbf(y1[0], y1[1]); w.w = pkbf(y1[2], y1[3]);
                        *(u32x4*)(xg + (size_t)row * DM + col) = w;
                    }
                }
                if (nxt) { ss += __shfl_xor(ss, 16); ss += __shfl_xor(ss, 32); if (fq == 0) unsafeAtomicAdd(rowsq_next + row, ss); }
            }
        }
    }
};

struct EpiSwiGLU {
    static constexpr bool PERM = true, AFTER_DRAIN = false;
    const float* rowsq; const float* bias; bf16_t* act;
    __device__ __forceinline__ void operator()(const f32x4 (&acc)[2][2][4][2], const Unit& u, int wr, int wc, int fr, int fq) const {
        const int pn = u.pn, pm = u.pm;
        const int v = pm >= 64 ? 2 : (pm >> 5);
        const int cb = pn * 256 + wc * 32 + 8 * fq;
        f32x4 bv[2][2];
#pragma unroll
        for (int bj = 0; bj < 2; ++bj)
#pragma unroll
            for (int n = 0; n < 2; ++n) bv[bj][n] = *(const f32x4*)(bias + v * FFI + cb + 128 * bj + 4 * n);
#pragma unroll
        for (int ai = 0; ai < 2; ++ai)
#pragma unroll
            for (int m = 0; m < 4; ++m) {
                const int row = pm * 256 + ai * 128 + wr * 64 + m * 16 + fr;
                const float rinv = rsqrtf(rowsq[row] * (1.f / DM) + EPSN);
                f32x4 o[2];
#pragma unroll
                for (int n = 0; n < 2; ++n) {
                    const f32x4 g = acc[ai][0][m][n] * rinv + bv[0][n], up = acc[ai][1][m][n] * rinv + bv[1][n];
#pragma unroll
                    for (int j = 0; j < 4; ++j) o[n][j] = g[j] * sigm(g[j]) * up[j];
                }
                u32x4 w; w.x = pkbf(o[0][0], o[0][1]); w.y = pkbf(o[0][2], o[0][3]); w.z = pkbf(o[1][0], o[1][1]); w.w = pkbf(o[1][2], o[1][3]);
                *(u32x4*)(act + (size_t)row * FFH + pn * 128 + wc * 32 + 8 * fq) = w;
            }
    }
};

#define AT_WAITV(n) asm volatile("s_waitcnt vmcnt(" #n ")" ::: "memory")
__device__ __forceinline__ void glds16(const void* gsrc, unsigned lds_dst) { unsigned keep;
    asm volatile("s_mov_b32 %0, m0\n\ts_mov_b32 m0, %2\n\ts_nop 0\n\tglobal_load_lds_dwordx4 %1, off\n\ts_mov_b32 m0, %0" : "=&s"(keep) : "v"(gsrc), "s"(lds_dst) : "memory"); }
__device__ __forceinline__ void glds16s(unsigned voff, const void* sbase, unsigned lds_dst) { unsigned keep;
    asm volatile("s_mov_b32 %0, m0\n\ts_mov_b32 m0, %3\n\ts_nop 0\n\tglobal_load_lds_dwordx4 %1, %2\n\ts_mov_b32 m0, %0" : "=&s"(keep) : "v"(voff), "s"(sbase), "s"(lds_dst) : "memory"); }
__device__ __forceinline__ s16x4 tr16(const LAS unsigned char* p) { return __builtin_bit_cast(s16x4, __builtin_amdgcn_ds_read_tr16_b64_v4i16((LAS s16x4*)p)); }

#define AT_SB() __builtin_amdgcn_sched_barrier(0)
__device__ __forceinline__ float fadd_s(float a, float b) { float r; asm("v_add_f32_e32 %0, %1, %2" : "=v"(r) : "v"(a), "v"(b)); return r; }
#define AT_WAIT_BAR(N) asm volatile("s_waitcnt vmcnt(" #N ") lgkmcnt(0)\n\ts_barrier" ::: "memory")
__device__ __forceinline__ void attn_unit(LAS unsigned char* lds, const bf16_t* Qb, const bf16_t* Kb, const bf16_t* Vb, bf16_t* mix,
                                          int b, int head, int qbase  , float lam, float post_scale, const float* subg) {
    int tid_l = threadIdx.x; asm volatile("" : "+v"(tid_l)); const int tid = tid_l, lane = tid & 63, wid = __builtin_amdgcn_readfirstlane(tid >> 6);
    const int r = lane & 31, h = lane >> 5;
    const int qg = wid & 3, c = wid >> 2;
    const int NT = qbase < CTXL ? (CTXL / 64) : NTK;
    const int qidx = qbase + qg * 32 + r;
    const size_t bh = (size_t)(b * 4 + head);
    const bf16_t* Qc = Qb + (bh * 2 + c) * (LK * 64);
    const unsigned char* K0 = (const unsigned char*)(Kb + (bh * 2) * (LK * 64));
    const unsigned char* V0 = (const unsigned char*)(Vb + bh * (LK * 128));
    const unsigned goff = (unsigned)(wid * 1024 + lane * 16);
    const unsigned ldsb = (unsigned)(size_t)lds;
    constexpr int VRING = 65536;
#define AT_DMA_K(t, slot) do { const unsigned _d = (unsigned)__builtin_amdgcn_readfirstlane((int)(ldsb + (unsigned)((slot) * 16384 + wid * 1024))); \
        glds16s(goff, K0 + (size_t)(t) * 8192, _d); glds16s(goff, K0 + (size_t)(LK * 128) + (size_t)(t) * 8192, _d + 8192u); } while (0)
#define AT_DMA_V(t, slot) do { const unsigned _d = (unsigned)__builtin_amdgcn_readfirstlane((int)(ldsb + (unsigned)(VRING + (slot) * 16384 + wid * 1024))); \
        glds16s(goff, V0 + (size_t)(t) * 16384, _d); glds16s(goff, V0 + (size_t)(t) * 16384 + 8192, _d + 8192u); } while (0)
    AT_DMA_K(0, 0); AT_DMA_V(0, 0); AT_DMA_K(1, 1);
    bf16x8 q[4];
#pragma unroll
    for (int d0 = 0; d0 < 4; ++d0) q[d0] = *(const bf16x8*)(Qc + (size_t)(qidx >> 6) * 4096 + (size_t)(2 * d0 + h) * 512 + (size_t)(qidx & 63) * 8);
    AT_DMA_K(2, 2);
    f32x16 O[4];
#pragma unroll
    for (int d = 0; d < 4; ++d)
#pragma unroll
        for (int i = 0; i < 16; ++i) O[d][i] = 0.f;
    float lsum = 0.f;
    const int koff = c * 8192 + h * 1024 + r * 16;
    const int g1 = (lane >> 4) & 1, qq = (lane & 15) >> 2, pp = lane & 3;
    const int vlo = VRING + 64 * (4 * h + qq) + 16 * (2 * g1 + ((pp >> 1) ^ h)) + 8 * (pp & 1);
    const int vhi = VRING + 2048 + 64 * (4 * h + qq) + 16 * (2 * (g1 ^ 1) + ((pp >> 1) ^ h)) + 8 * (pp & 1);
    bf16x8 kf[8];
#define AT_KLOAD2(j, slot) do { kf[2 * (j)] = *(const LAS bf16x8*)(lds + (slot) * 16384 + koff + (j) * 2048); kf[2 * (j) + 1] = *(const LAS bf16x8*)(lds + (slot) * 16384 + koff + (j) * 2048 + 512); } while (0)
#define AT_VFRAG(dst, vp, n) do { const s16x4 lo_ = tr16((vp) + vlo + ((n) >> 2) * 4096 + ((n) & 3) * 512), hi_ = tr16((vp) + vhi + ((n) >> 2) * 4096 + ((n) & 3) * 512); \
        dst = (bf16x8){lo_[0], lo_[1], lo_[2], lo_[3], hi_[0], hi_[1], hi_[2], hi_[3]}; } while (0)
    f32x16 pA0, pA1, pB0, pB1;
    u32x4 pw0, pw1, pw2, pw3;
    const f32x16 zero16 = {0.f, 0.f, 0.f, 0.f, 0.f, 0.f, 0.f, 0.f, 0.f, 0.f, 0.f, 0.f, 0.f, 0.f, 0.f, 0.f};
    int sl_prev = 0, sl_cur = 0, sl_next = 1;
#define AT_ROT() do { sl_prev = sl_cur; sl_cur = sl_next; sl_next = (sl_next == 2) ? 0 : sl_next + 1; } while (0)
    AT_WAIT_BAR(6);
    AT_KLOAD2(0, 0); AT_KLOAD2(1, 0); AT_KLOAD2(2, 0); AT_KLOAD2(3, 0);
    pA0 = __builtin_amdgcn_mfma_f32_32x32x16_bf16(kf[0], q[0], zero16, 0, 0, 0); pA1 = __builtin_amdgcn_mfma_f32_32x32x16_bf16(kf[1], q[0], zero16, 0, 0, 0);
#pragma unroll
    for (int d0 = 1; d0 < 4; ++d0) { pA0 = __builtin_amdgcn_mfma_f32_32x32x16_bf16(kf[2 * d0], q[d0], pA0, 0, 0, 0); pA1 = __builtin_amdgcn_mfma_f32_32x32x16_bf16(kf[2 * d0 + 1], q[d0], pA1, 0, 0, 0); }
#pragma unroll
    for (int i = 0; i < 16; ++i) { pA0[i] = __builtin_amdgcn_exp2f(pA0[i]); pA1[i] = __builtin_amdgcn_exp2f(pA1[i]); }
    AT_WAIT_BAR(0);
    AT_DMA_K(3, 3); AT_DMA_V(1, 1);
    AT_ROT();
    AT_KLOAD2(0, 1); AT_KLOAD2(1, 1);
    AT_WAIT_BAR(4);
#define AT_PK(P, B) pkbf(P[B], P[B + 1])
#define AT_GAPA(MF, P, B, PW, X, Y) do { MF; sacc = fadd_s(sacc, P[B]); sacc = fadd_s(sacc, P[B + 1]); sacc = fadd_s(sacc, P[B + 2]); sacc = fadd_s(sacc, P[B + 3]); PW.X = AT_PK(P, B); PW.Y = AT_PK(P, B + 2); AT_SB(); } while (0)
#define AT_GAPB(n, C, B) do { if ((n) + 2 < 16) AT_VFRAG(vfr[((n) + 2) % 3], vp_, (n) + 2); \
        O[(n) & 3] = __builtin_amdgcn_mfma_f32_32x32x16_bf16(vfr[(n) % 3], __builtin_bit_cast(bf16x8, pwv[(n) >> 2]), O[(n) & 3], 0, 0, 0); \
        C[B] = __builtin_amdgcn_exp2f(C[B]); C[B + 1] = __builtin_amdgcn_exp2f(C[B + 1]); AT_SB(); } while (0)
#define AT_STEP(C0, C1, P0, P1, t, GK, GV, GL) do { AT_SB(); \
        const LAS unsigned char* vp_ = lds + sl_prev * 16384; float sacc = 0.f; \
        AT_KLOAD2(2, (t) & 3); AT_KLOAD2(3, (t) & 3); AT_SB(); \
        AT_GAPA(C0 = __builtin_amdgcn_mfma_f32_32x32x16_bf16(kf[0], q[0], zero16, 0, 0, 0), P0, 0, pw0, x, y); \
        AT_GAPA(C1 = __builtin_amdgcn_mfma_f32_32x32x16_bf16(kf[1], q[0], zero16, 0, 0, 0), P0, 4, pw0, z, w); \
        AT_GAPA(C0 = __builtin_amdgcn_mfma_f32_32x32x16_bf16(kf[2], q[1], C0, 0, 0, 0), P0, 8, pw1, x, y); \
        AT_GAPA(C1 = __builtin_amdgcn_mfma_f32_32x32x16_bf16(kf[3], q[1], C1, 0, 0, 0), P0, 12, pw1, z, w); \
        AT_GAPA(C0 = __builtin_amdgcn_mfma_f32_32x32x16_bf16(kf[4], q[2], C0, 0, 0, 0), P1, 0, pw2, x, y); \
        AT_GAPA(C1 = __builtin_amdgcn_mfma_f32_32x32x16_bf16(kf[5], q[2], C1, 0, 0, 0), P1, 4, pw2, z, w); \
        bf16x8 vfr[3]; AT_VFRAG(vfr[0], vp_, 0); AT_VFRAG(vfr[1], vp_, 1); AT_SB(); \
        AT_GAPA(C0 = __builtin_amdgcn_mfma_f32_32x32x16_bf16(kf[6], q[3], C0, 0, 0, 0), P1, 8, pw3, x, y); \
        AT_GAPA(C1 = __builtin_amdgcn_mfma_f32_32x32x16_bf16(kf[7], q[3], C1, 0, 0, 0), P1, 12, pw3, z, w); \
        lsum += sacc; \
        if (GK) AT_DMA_K((t) + 3, ((t) + 3) & 3); if (GV) AT_DMA_V((t) + 1, sl_next); \
        const u32x4 pwv[4] = {pw0, pw1, pw2, pw3}; AT_SB(); \
        AT_GAPB(0, C0, 0); AT_GAPB(1, C0, 2); AT_GAPB(2, C0, 4); AT_GAPB(3, C0, 6); \
        if (GL) { AT_KLOAD2(0, ((t) + 1) & 3); AT_SB(); } AT_GAPB(4, C0, 8); \
        if (GL) { AT_KLOAD2(1, ((t) + 1) & 3); AT_SB(); } AT_GAPB(5, C0, 10); \
        AT_GAPB(6, C0, 12); AT_GAPB(7, C0, 14); \
        AT_GAPB(8, C1, 0); AT_GAPB(9, C1, 2); AT_GAPB(10, C1, 4); AT_GAPB(11, C1, 6); AT_GAPB(12, C1, 8); AT_GAPB(13, C1, 10); AT_GAPB(14, C1, 12); AT_GAPB(15, C1, 14); \
    } while (0)
#define AT_ENDW(tt) do { if ((tt) + 3 < NT) { AT_WAIT_BAR(4); } else if ((tt) + 2 < NT) { AT_WAIT_BAR(2); } else { AT_WAIT_BAR(0); } } while (0)
    int t = 1;
    for (; t + 5 < NT; t += 2) {
        AT_STEP(pB0, pB1, pA0, pA1, t, true, true, true);     AT_WAIT_BAR(4); AT_ROT();
        AT_STEP(pA0, pA1, pB0, pB1, t + 1, true, true, true); AT_WAIT_BAR(4); AT_ROT();
    }
    for (; t + 1 < NT; t += 2) {
        AT_STEP(pB0, pB1, pA0, pA1, t, (t + 3 < NT), (t + 1 < NT), (t + 1 < NT));         AT_ENDW(t);     AT_ROT();
        AT_STEP(pA0, pA1, pB0, pB1, t + 1, (t + 4 < NT), (t + 2 < NT), (t + 2 < NT));     AT_ENDW(t + 1); AT_ROT();
    }
    AT_STEP(pB0, pB1, pA0, pA1, NT - 1, false, false, false);
    {
        float sacc = 0.f;
#pragma unroll
        for (int i = 0; i < 16; ++i) sacc += pB0[i] + pB1[i];
        lsum += sacc;
        pw0 = (u32x4){AT_PK(pB0, 0), AT_PK(pB0, 2), AT_PK(pB0, 4), AT_PK(pB0, 6)}; pw1 = (u32x4){AT_PK(pB0, 8), AT_PK(pB0, 10), AT_PK(pB0, 12), AT_PK(pB0, 14)};
        pw2 = (u32x4){AT_PK(pB1, 0), AT_PK(pB1, 2), AT_PK(pB1, 4), AT_PK(pB1, 6)}; pw3 = (u32x4){AT_PK(pB1, 8), AT_PK(pB1, 10), AT_PK(pB1, 12), AT_PK(pB1, 14)};
        const u32x4 pwv[4] = {pw0, pw1, pw2, pw3};
        const LAS unsigned char* vp_ = lds + sl_cur * 16384;
#pragma unroll
        for (int n = 0; n < 16; ++n) { bf16x8 vf_; AT_VFRAG(vf_, vp_, n); O[n & 3] = __builtin_amdgcn_mfma_f32_32x32x16_bf16(vf_, __builtin_bit_cast(bf16x8, pwv[n >> 2]), O[n & 3], 0, 0, 0); }
    }
#undef AT_STEP
#undef AT_GAPA
#undef AT_GAPB
#undef AT_ENDW
#undef AT_PK
#undef AT_ROT
#undef AT_KLOAD2
#undef AT_VFRAG
#undef AT_DMA_K
#undef AT_DMA_V
    asm volatile("s_waitcnt vmcnt(0) lgkmcnt(0)" ::: "memory");
    __builtin_amdgcn_s_barrier();
    asm volatile("" ::: "memory");
    const float lt = lsum + __shfl_xor(lsum, 32);
    int tid_e = threadIdx.x; asm volatile("" : "+v"(tid_e));
    const int lane_e = tid_e & 63, h_e = lane_e >> 5, qidx_e = qbase + qg * 32 + (lane_e & 31);
    LAS float* X = (LAS float*)lds + qg * 4096 + lane_e;
    if (c == 1) {
        const float sc = lam / lt;
#pragma unroll
        for (int d = 0; d < 4; ++d)
#pragma unroll
            for (int i = 0; i < 16; ++i) X[(d * 16 + i) * 64] = O[d][i] * sc;
    }
    asm volatile("s_waitcnt lgkmcnt(0)" ::: "memory");
    __builtin_amdgcn_s_barrier();
    asm volatile("" ::: "memory");
    if (c == 0) {
        const float i0 = 1.f / lt;
        float ss = 0.f;
#pragma unroll
        for (int d = 0; d < 4; ++d)
#pragma unroll
            for (int i = 0; i < 16; ++i) { const float o = O[d][i] * i0 - X[(d * 16 + i) * 64]; O[d][i] = o; ss += o * o; }
        ss += __shfl_xor(ss, 32);
        const float rn = rsqrtf(ss * (1.f / 128.f) + EPSN) * post_scale;
        const int qrow = qbase < CTXL ? (MLAT + b * CTXL + qidx_e) : (b * SEQ + qidx_e - CTXL);
        bf16_t* orow = mix + (size_t)qrow * DM + head * 128;
#pragma unroll
        for (int d = 0; d < 4; ++d)
#pragma unroll
            for (int i4 = 0; i4 < 4; ++i4) {
                const int dv = 32 * d + 8 * i4 + 4 * h_e;
                const f32x4 g = *(const f32x4*)(subg + dv);
                u32x2 w; w.x = pkbf(O[d][4 * i4] * rn * g[0], O[d][4 * i4 + 1] * rn * g[1]); w.y = pkbf(O[d][4 * i4 + 2] * rn * g[2], O[d][4 * i4 + 3] * rn * g[3]);
                *(u32x2*)(orow + dv) = w;
            }
    }
    asm volatile("s_waitcnt vmcnt(0) lgkmcnt(0)" ::: "memory");
    __builtin_amdgcn_s_barrier();
    asm volatile("" ::: "memory");
}

constexpr int PPITCH = 260;
template <int W> __device__ __forceinline__ void pool_win(const float* up, int seq0, int L, int tfirst, int ch, LAS float* Pout) {
    constexpr int LO = W / 2, HI = W - W / 2, NV = 31 + W;
    float u[NV];
#pragma unroll
    for (int j = 0; j < NV; ++j) { const int tt = tfirst - LO + j; u[j] = (tt >= 0 && tt < L) ? up[(size_t)(seq0 + tt) * 256 + ch] : 0.f; }
    float c[NV + 1]; c[0] = 0.f;
#pragma unroll
    for (int j = 0; j < NV; ++j) c[j + 1] = c[j] + u[j];
#pragma unroll
    for (int i = 0; i < 32; ++i) {
        const int t = tfirst + i; int lo = t - LO, hi = t + HI; lo = lo < 0 ? 0 : lo; hi = hi > L ? L : hi;
        Pout[i * PPITCH] = (c[i + W] - c[i]) * __builtin_amdgcn_rcpf((float)(hi - lo)) - u[i + LO];
    }
}
__device__ __forceinline__ void pool_unit(LAS unsigned char* lds, const float* upool, const float* pw  , const float* pscale, bf16_t* mix, int row0) {
    int tid_l = threadIdx.x; asm volatile("" : "+v"(tid_l)); const int tid = tid_l, lane = tid & 63, wid = __builtin_amdgcn_readfirstlane(tid >> 6);
    LAS float* P = (LAS float*)lds;
    int seq0, L;
    if (row0 < MLAT) { seq0 = row0 & ~(SEQ - 1); L = SEQ; } else { seq0 = MLAT + ((row0 - MLAT) & ~(CTXL - 1)); L = CTXL; }
    const int g = wid & 3, half = wid >> 2;
    {
        const int ch = g * 64 + lane, tfirst = row0 - seq0 + half * 32;
        LAS float* Pout = P + (half * 32) * PPITCH + ch;
        if (g == 0) pool_win<2>(upool, seq0, L, tfirst, ch, Pout);
        else if (g == 1) pool_win<4>(upool, seq0, L, tfirst, ch, Pout);
        else if (g == 2) pool_win<8>(upool, seq0, L, tfirst, ch, Pout);
        else pool_win<16>(upool, seq0, L, tfirst, ch, Pout);
    }
    const int r = lane & 31, h = lane >> 5;
    bf16x8 bw[4][2];
#pragma unroll
    for (int ks = 0; ks < 4; ++ks)
#pragma unroll
        for (int nt = 0; nt < 2; ++nt) {
            const float* wp = pw + (size_t)(g * 64 + 16 * ks + 8 * h) * 64 + 32 * nt + r;
            u32x4 w; w.x = pkbf(wp[0], wp[64]); w.y = pkbf(wp[128], wp[192]); w.z = pkbf(wp[256], wp[320]); w.w = pkbf(wp[384], wp[448]);
            bw[ks][nt] = __builtin_bit_cast(bf16x8, w);
        }
    const float sc0 = pscale[g * 64 + r], sc1 = pscale[g * 64 + 32 + r];
    __syncthreads();
    {
        f32x16 d0, d1;
#pragma unroll
        for (int i = 0; i < 16; ++i) { d0[i] = 0.f; d1[i] = 0.f; }
        const LAS float* pa = P + (half * 32 + r) * PPITCH + g * 64 + 8 * h;
#pragma unroll
        for (int ks = 0; ks < 4; ++ks) {
            const f32x4 a0 = *(const LAS f32x4*)(pa + 16 * ks), a1 = *(const LAS f32x4*)(pa + 16 * ks + 4);
            u32x4 w; w.x = pkbf(a0[0], a0[1]); w.y = pkbf(a0[2], a0[3]); w.z = pkbf(a1[0], a1[1]); w.w = pkbf(a1[2], a1[3]);
            const bf16x8 af = __builtin_bit_cast(bf16x8, w);
            d0 = __builtin_amdgcn_mfma_f32_32x32x16_bf16(af, bw[ks][0], d0, 0, 0, 0);
            d1 = __builtin_amdgcn_mfma_f32_32x32x16_bf16(af, bw[ks][1], d1, 0, 0, 0);
        }
        bf16_t* ob = mix + (size_t)(row0 + half * 32) * DM + 512 + g * 64 + r;
#pragma unroll
        for (int i = 0; i < 16; ++i) {
            const int tk = (i & 3) + 8 * (i >> 2) + 4 * h;
            const unsigned bits = pkbf(d0[i] * sc0, d1[i] * sc1);
            ob[(size_t)tk * DM] = (bf16_t)(bits & 0xffffu);
            ob[(size_t)tk * DM + 32] = (bf16_t)(bits >> 16);
        }
    }
    __syncthreads();
}

__device__ __forceinline__ void conv_unit(LAS unsigned char* lds, const float* uconv, const float* cw  , const float* cb, const float* lng, const float* lnb, bf16_t* mix, int row0) {
    int tid_l = threadIdx.x; asm volatile("" : "+v"(tid_l)); const int tid = tid_l, lane = tid & 63, wid = tid >> 6;
    LAS float* Y = (LAS float*)lds;
    int seq0, L;
    if (row0 < MLAT) { seq0 = row0 & ~(SEQ - 1); L = SEQ; } else { seq0 = MLAT + ((row0 - MLAT) & ~(CTXL - 1)); L = CTXL; }
    {
        const int ch = tid & 255, half = tid >> 8;
        const int t0 = row0 - seq0 + half * 32;
        float uwin[62];
#pragma unroll
        for (int j = 0; j < 62; ++j) { const int tt = t0 - 15 + j; uwin[j] = (tt >= 0 && tt < L) ? uconv[(size_t)(seq0 + tt) * 256 + ch] : 0.f; }
        float w[31];
#pragma unroll
        for (int j = 0; j < 31; ++j) w[j] = cw[j * 256 + ch];
        const float bias = cb[ch];
#pragma unroll
        for (int i = 0; i < 32; ++i) {
            float a = bias;
#pragma unroll
            for (int j = 0; j < 31; ++j) a += uwin[i + j] * w[j];
            Y[(half * 32 + i) * 256 + ch] = a;
        }
    }
    __syncthreads();
    {
        const f32x4 g4 = *(const f32x4*)(lng + 4 * lane), b4 = *(const f32x4*)(lnb + 4 * lane);
        f32x4 y[8]; float s1[8], s2[8];
#pragma unroll
        for (int i = 0; i < 8; ++i) {
            y[i] = *(const LAS f32x4*)(Y + (wid * 8 + i) * 256 + 4 * lane);
            s1[i] = (y[i][0] + y[i][1]) + (y[i][2] + y[i][3]);
            s2[i] = (y[i][0] * y[i][0] + y[i][1] * y[i][1]) + (y[i][2] * y[i][2] + y[i][3] * y[i][3]);
        }
#pragma unroll
        for (int o = 1; o < 64; o <<= 1)
#pragma unroll
            for (int i = 0; i < 8; ++i) { s1[i] += __shfl_xor(s1[i], o); s2[i] += __shfl_xor(s2[i], o); }
#pragma unroll
        for (int i = 0; i < 8; ++i) {
            const int tk = wid * 8 + i;
            const float mu = s1[i] * (1.f / 256.f);
            const float var = fmaxf(s2[i] * (1.f / 256.f) - mu * mu, 0.f);
            const float rs = rsqrtf(var + EPSN);
            f32x4 z = (y[i] - mu) * rs * g4 + b4;
#pragma unroll
            for (int j = 0; j < 4; ++j) z[j] = z[j] * sigm(z[j]);
            u32x2 w; w.x = pkbf(z[0], z[1]); w.y = pkbf(z[2], z[3]);
            *(u32x2*)(mix + (size_t)(row0 + tk) * DM + 768 + 4 * lane) = w;
        }
    }
    __syncthreads();
}

__device__ __forceinline__ void ctx_slice_gemm(LAS unsigned char* lds, const bf16_t* A  , const bf16_t* Bt  , int K,
                                               const float* res_ctx, float* dst_ctx, const float* gate2  , const float* ng, const float* nsc2  ,
                                               bf16_t* xg, float* rowsq_next, int blk) {
    int tid_l = threadIdx.x; asm volatile("" : "+v"(tid_l)); const int tid = tid_l, lane = tid & 63, wid = __builtin_amdgcn_readfirstlane(tid >> 6), r = lane & 31, h = lane >> 5;
    const int row0 = (blk >> 5) * 64, col0 = (blk & 31) * 32;
    const int kw = K >> 3, kbeg = wid * kw;
    const bf16_t* a0 = A + (size_t)(MLAT + row0 + r) * K + kbeg + 8 * h;
    const bf16_t* a1 = a0 + (size_t)32 * K;
    const bf16_t* bp = Bt + (size_t)(col0 + r) * K + kbeg + 8 * h;
    f32x16 acc0, acc1;
#pragma unroll
    for (int i = 0; i < 16; ++i) { acc0[i] = 0.f; acc1[i] = 0.f; }
#pragma unroll 4
    for (int k = 0; k < kw; k += 32) {
        const bf16x8 fa0 = *(const bf16x8*)(a0 + k), fa1 = *(const bf16x8*)(a1 + k), fb = *(const bf16x8*)(bp + k);
        const bf16x8 ga0 = *(const bf16x8*)(a0 + k + 16), ga1 = *(const bf16x8*)(a1 + k + 16), gb = *(const bf16x8*)(bp + k + 16);
        acc0 = __builtin_amdgcn_mfma_f32_32x32x16_bf16(fa0, fb, acc0, 0, 0, 0);
        acc1 = __builtin_amdgcn_mfma_f32_32x32x16_bf16(fa1, fb, acc1, 0, 0, 0);
        acc0 = __builtin_amdgcn_mfma_f32_32x32x16_bf16(ga0, gb, acc0, 0, 0, 0);
        acc1 = __builtin_amdgcn_mfma_f32_32x32x16_bf16(ga1, gb, acc1, 0, 0, 0);
    }
    LAS float* part = (LAS float*)lds;
#pragma unroll
    for (int i = 0; i < 16; ++i) { part[((wid * 2 + 0) * 16 + i) * 64 + lane] = acc0[i]; part[((wid * 2 + 1) * 16 + i) * 64 + lane] = acc1[i]; }
    __syncthreads();
    {
        const int sub = wid, g = sub >> 2, q4 = sub & 3, col = col0 + r;
        const float gt = gate2[col];
        const bool nxt = ng != nullptr;
        const float gs = nxt ? ng[col] * (1.f + nsc2[col]) : 0.f;
#pragma unroll
        for (int j = 0; j < 4; ++j) {
            const int i = q4 * 4 + j;
            float s = 0.f;
#pragma unroll
            for (int w = 0; w < 8; ++w) s += part[((w * 2 + g) * 16 + i) * 64 + lane];
            const int rr = row0 + 32 * g + 8 * q4 + 4 * h + j;
            const float x = res_ctx[(size_t)rr * DM + col] + gt * s;
            dst_ctx[(size_t)rr * DM + col] = x;
            if (nxt) {
                xg[(size_t)(MLAT + rr) * DM + col] = (bf16_t)(pkbf(x * gs, 0.f) & 0xffffu);
                float ss = x * x;
                ss += __shfl_xor(ss, 1); ss += __shfl_xor(ss, 2); ss += __shfl_xor(ss, 4); ss += __shfl_xor(ss, 8); ss += __shfl_xor(ss, 16);
                if (r == 0) unsafeAtomicAdd(rowsq_next + MLAT + rr, ss);
            }
        }
    }
    __syncthreads();
}

__device__ __forceinline__ void transpose_item(const float* W, int K, int N, bf16_t* WT, int k0, int n_src, int n_dst, LAS float* scr, int lane) {
#pragma unroll 8
    for (int i = 0; i < 32; ++i) { const int kk = 2 * i + (lane >> 5); scr[kk * 33 + (lane & 31)] = W[(size_t)(k0 + kk) * N + n_src + (lane & 31)]; }
    asm volatile("s_waitcnt lgkmcnt(0)" ::: "memory");
    const int c = lane & 7;
#pragma unroll
    for (int j = 0; j < 4; ++j) {
        const int n = (lane >> 3) + 8 * j; const LAS float* s = scr + (8 * c) * 33 + n;
        u32x4 o; o.x = pkbf(s[0 * 33], s[1 * 33]); o.y = pkbf(s[2 * 33], s[3 * 33]); o.z = pkbf(s[4 * 33], s[5 * 33]); o.w = pkbf(s[6 * 33], s[7 * 33]);
        *(u32x4*)(WT + (size_t)(n_dst + n) * K + k0 + 8 * c) = o;
    }
    asm volatile("s_waitcnt lgkmcnt(0)" ::: "memory");
}

__device__ __forceinline__ void convert_layer(const Params& p, LAS unsigned char* lds, int l, int gwi, int ngw, int lane, int wid) {
    LAS float* scr = (LAS float*)(lds + wid * 16384);
    unsigned char* wl = p.ws + WS_W + (size_t)l * W_LAYER;
    for (int it = gwi; it < 5888; it += ngw) {
        int rr = it;
        if (rr < 1152) { const int kb = rr / 72, nb = rr % 72; transpose_item(p.w_in + (size_t)l * DM * INW, DM, INW, (bf16_t*)(wl + W_IN), 64 * kb, perm_in(32 * nb), 32 * nb, scr, lane); continue; } rr -= 1152;
        if (rr < 512) { const int kb = rr / 32, nb = rr % 32; transpose_item(p.w_out + (size_t)l * DM * DM, DM, DM, (bf16_t*)(wl + W_OUT), 64 * kb, 32 * nb, 32 * nb, scr, lane); continue; } rr -= 512;
        if (rr < 2816) { const int kb = rr / 176, nb = rr % 176; transpose_item(p.w_ffn_in + (size_t)l * DM * FFI, DM, FFI, (bf16_t*)(wl + W_FI), 64 * kb, perm_fi(32 * nb), 32 * nb, scr, lane); continue; } rr -= 2816;
        { const int kb = rr / 32, nb = rr % 32; transpose_item(p.w_ffn_out + (size_t)l * FFH * DM, FFH, DM, (bf16_t*)(wl + W_FO), 64 * kb, 32 * nb, 32 * nb, scr, lane); }
    }
}
__device__ __forceinline__ void bias_rows(const bf16_t* Wt, int N, const float* sh  , float* bias  , int gwi, int ngw, int lane) {
    f32x4 s[3][4];
#pragma unroll
    for (int v = 0; v < 3; ++v)
#pragma unroll
        for (int j = 0; j < 4; ++j) s[v][j] = *(const f32x4*)(sh + v * 6144 + (j >> 1) * 512 + 8 * lane + 4 * (j & 1));
    for (int n = gwi; n < N; n += ngw) {
        const u32x4 w0 = *(const u32x4*)(Wt + (size_t)n * DM + 8 * lane), w1 = *(const u32x4*)(Wt + (size_t)n * DM + 512 + 8 * lane);
        float wf[16];
#pragma unroll
        for (int j = 0; j < 4; ++j) { wf[2 * j] = __uint_as_float(w0[j] << 16); wf[2 * j + 1] = __uint_as_float(w0[j] & 0xffff0000u); wf[8 + 2 * j] = __uint_as_float(w1[j] << 16); wf[8 + 2 * j + 1] = __uint_as_float(w1[j] & 0xffff0000u); }
#pragma unroll
        for (int v = 0; v < 3; ++v) {
            float a = 0.f;
#pragma unroll
            for (int j = 0; j < 16; ++j) a += wf[j] * s[v][j >> 2][j & 3];
            a = wave_sum(a);
            if (lane == 0) bias[(size_t)v * N + n] = a;
        }
    }
}
__device__ __forceinline__ void bias_layer(const Params& p, int l, int gwi, int ngw, int lane) {
    unsigned char* ws = p.ws;
    const float* modl = (const float*)(ws + Z_MOD) + (size_t)(l * 3) * 6144;
    const unsigned char* wl = ws + WS_W + (size_t)l * W_LAYER;
    bias_rows((const bf16_t*)(wl + W_IN), INW, modl, (float*)(ws + Z_BIAS1) + (size_t)(l * 3) * INW, gwi, ngw, lane);
    bias_rows((const bf16_t*)(wl + W_FI), FFI, modl + 3 * DM, (float*)(ws + Z_BIAS2) + (size_t)(l * 3) * FFI, gwi, ngw, lane);
}
__device__ __forceinline__ void phase_p0a(const Params& p, LAS unsigned char* lds) {
    int tid_l = threadIdx.x; asm volatile("" : "+v"(tid_l)); const int tid = tid_l, lane = tid & 63, wid = tid >> 6;
    const int G = gridDim.x, gw = blockIdx.x * 8 + wid, NGW = G * 8;
    unsigned char* ws = p.ws;
    float* MOD = (float*)(ws + Z_MOD);
    {
        const int gt = blockIdx.x * 512 + tid;
        if (gt < 2048) { const int pos = gt >> 4, fi = gt & 15; const float inv = powf(10000.f, -(float)fi * (1.f / 16.f)); const float ang = (float)pos * inv;
            float* rp = (float*)(ws + WS_ROPE); rp[2 * gt] = cosf(ang); rp[2 * gt + 1] = sinf(ang); }
        if (gt >= 2048 && gt < 2048 + DEPTH) { const int l = gt - 2048; float s1 = 0.f, s2 = 0.f;
            for (int i = 0; i < 64; ++i) { s1 += p.lq1[l * 64 + i] * p.lk1[l * 64 + i]; s2 += p.lq2[l * 64 + i] * p.lk2[l * 64 + i]; }
            const float li = 0.8f - 0.6f * expf(-0.3f * (float)l);
            ((float*)(ws + WS_LAM))[l] = expf(s1) - expf(s2) + li; }
    }
    for (int it = gw; it < DEPTH * 24 * 16; it += NGW) {
        const int l = it / 384, rem = it % 384, cgp = rem >> 4, kc = rem & 15, col = cgp * 256 + 4 * lane, k0 = kc * 64;
        f32x4 a0 = {0.f, 0.f, 0.f, 0.f}, a1 = a0, a2 = a0;
        const float* W = p.w_mod + ((size_t)l * DM + k0) * 6144 + col;
#pragma unroll 8
        for (int kk = 0; kk < 64; ++kk) {
            const f32x4 w = *(const f32x4*)(W + (size_t)kk * 6144);
            const float s0 = siluf(p.c[k0 + kk]), s1 = siluf(p.c[DM + k0 + kk]), s2 = siluf(p.c_ctx[k0 + kk]);
            a0 += w * s0; a1 += w * s1; a2 += w * s2;
        }
        if (kc == 0) { const f32x4 bm = *(const f32x4*)(p.b_mod + l * 6144 + col); a0 += bm; a1 += bm; a2 += bm; }
        float* d0 = MOD + (size_t)(l * 3) * 6144 + col;
#pragma unroll
        for (int j = 0; j < 4; ++j) { unsafeAtomicAdd(d0 + j, a0[j]); unsafeAtomicAdd(d0 + 6144 + j, a1[j]); unsafeAtomicAdd(d0 + 2 * 6144 + j, a2[j]); }
    }
    for (int l = 0; l < DEPTH; ++l) convert_layer(p, lds, l, gw, NGW, lane, wid);
}

__device__ __forceinline__ void phase_p0b(const Params& p) {
    int tid_l = threadIdx.x; asm volatile("" : "+v"(tid_l)); const int tid = tid_l, lane = tid & 63, wid = tid >> 6;
    const int G = gridDim.x, gw = blockIdx.x * 8 + wid, NGW = G * 8;
    unsigned char* ws = p.ws;
    const float* MOD = (const float*)(ws + Z_MOD);
    bias_layer(p, 0, gw, NGW, lane);
    bf16_t* XG = (bf16_t*)(ws + WS_XG);
    float* rs = (float*)(ws + Z_ROWSQ);
    for (int row0 = gw; row0 < MALL; row0 += 2 * NGW) {
        const int rows[2] = {row0, row0 + NGW};
        f32x4 xv[2][4]; int vv[2];
#pragma unroll
        for (int q = 0; q < 2; ++q) {
            const int row = rows[q] < MALL ? rows[q] : row0;
            const float* src;
            if (row < MLAT) { src = p.x + (size_t)row * DM; vv[q] = row >> 13; } else { src = p.ctx + (size_t)(row - MLAT) * DM; vv[q] = 2; }
#pragma unroll
            for (int j = 0; j < 4; ++j) xv[q][j] = *(const f32x4*)(src + 4 * lane + 256 * j);
        }
#pragma unroll
        for (int q = 0; q < 2; ++q) {
            if (rows[q] >= MALL) continue;
            const int row = rows[q];
            const float* sc = MOD + (size_t)vv[q] * 6144 + DM;
            float ss = 0.f;
#pragma unroll
            for (int j = 0; j < 4; ++j) {
                const int col = 4 * lane + 256 * j;
                const f32x4 x4 = xv[q][j], g = *(const f32x4*)(p.norm1_g + col), s = *(const f32x4*)(sc + col);
                ss += (x4[0] * x4[0] + x4[1] * x4[1]) + (x4[2] * x4[2] + x4[3] * x4[3]);
                const f32x4 y = x4 * g * (s + 1.f);
                u32x2 w; w.x = pkbf(y[0], y[1]); w.y = pkbf(y[2], y[3]);
                *(u32x2*)(XG + (size_t)row * DM + col) = w;
            }
            ss = wave_sum(ss);
            if (lane == 0) rs[row] = ss;
        }
    }
}

constexpr int IPA_QKV = 66 * 6, IPA_N = 512, IPB_N = 66 * 9 - IPA_N;
__device__ __forceinline__ void ip_tail_tile(int a2, Unit& u) { u.pm = a2 / 3; u.pn = 6 + a2 % 3; }
struct InProjOrderA {
    int G, c;
    __device__ bool next(int i, Unit& u) const {
        const int L = i * G + c; if (L >= IPA_N) return false;
        const int a = (L % pg8::NXCD) * (IPA_N / pg8::NXCD) + L / pg8::NXCD;
        if (a < IPA_QKV) { const int gid = a / 48, fm = gid * 8, gsz = (66 - fm) < 8 ? (66 - fm) : 8, w = a % 48; u.pm = fm + w % gsz; u.pn = w / gsz; }
        else ip_tail_tile(a - IPA_QKV, u);
        return true;
    }
    __device__ __forceinline__ void a_ready(const Unit&) const {}
    __device__ __forceinline__ void done(const Unit&) const {}
};
struct InProjOrderB {
    int G, c;
    __device__ bool next(int i, Unit& u) const { const int L = i * G + c; if (L >= IPB_N) return false; ip_tail_tile(IPA_N - IPA_QKV + L, u); return true; }
    __device__ __forceinline__ void a_ready(const Unit&) const {}
    __device__ __forceinline__ void done(const Unit&) const {}
};

__global__ void __launch_bounds__(512, 2) fwd_megakernel(Params p) {
    extern __shared__ __attribute__((aligned(16))) unsigned char lds_raw[];
    LAS unsigned char* lds = (LAS unsigned char*)lds_raw;
    cg::grid_group grid = cg::this_grid();
    const int G = gridDim.x, bx = blockIdx.x;
#define PH_WS() unsigned char* ws = p.ws; asm volatile("" : "+s"(ws))
#define MOD ((const float*)(ws + Z_MOD))
#define ROWSQ ((float*)(ws + Z_ROWSQ))
#define XG ((bf16_t*)(ws + WS_XG))
#define QB ((bf16_t*)(ws + WS_Q))
#define KB ((bf16_t*)(ws + WS_K))
#define VB ((bf16_t*)(ws + WS_V))
#define UP ((float*)(ws + WS_UP))
#define UC ((float*)(ws + WS_UC))
#define MIX ((bf16_t*)(ws + WS_MIX))
#define ACT ((bf16_t*)(ws + WS_ACT))
#define XC ((float*)(ws + WS_XC))
#define wl (ws + WS_W + (size_t)l * W_LAYER)
#define modl (MOD + (size_t)(l * 3) * 6144)
#define rs1 (ROWSQ + (size_t)(2 * l) * MALL)
#define rs2 (ROWSQ + (size_t)(2 * l + 1) * MALL)

    volatile LAS unsigned* bst = (volatile LAS unsigned*)(lds + 131072 + 64);
    if (threadIdx.x < 2) bst[threadIdx.x] = 0u;
    __syncthreads();
    { PH_WS(); (void)xcd_barrier_post((unsigned*)(ws + Z_BAR), bst); }
#define GRID_BAR() do { XcdBarrier xb2_; unsigned* barp_ = (unsigned*)(p.ws + Z_BAR); asm volatile("" : "+s"(barp_)); xb2_.bar = barp_; xb2_.x = xb_xcc_id(); xb2_.st = bst; xcd_barrier(xb2_); } while (0)

    phase_p0a(p, lds);
    grid.sync();
    phase_p0b(p);
    GRID_BAR();

#pragma nounroll
    for (int l = 0; l < DEPTH; ++l) {
        const bool last = l == DEPTH - 1;
        {
            PH_WS();
            pg8::Gemm g{XG, (const bf16_t*)(wl + W_IN), MALL, INW, DM}; const InProjOrderA S{G, bx};
            EpiInProj E{rs1, (const float*)(ws + Z_BIAS1) + (size_t)(l * 3) * INW, p.q_norm_g + l * 64, p.k_norm_g + l * 64, (const float*)(ws + WS_ROPE), QB, KB, VB, UP, UC};
            pg8::gemm_phase<EpiInProj, InProjOrderA, true, true>(lds, g, S, E);
        }
        GRID_BAR();
        {
            PH_WS();
            unsigned* cntw = (unsigned*)(ws + Z_CNT) + 64 * l;
            const int nlate = IPB_N < G ? IPB_N : 0;
            if (bx < IPB_N) {
                pg8::Gemm g{XG, (const bf16_t*)(wl + W_IN), MALL, INW, DM}; const InProjOrderB S{G, bx};
                EpiInProj E{rs1, (const float*)(ws + Z_BIAS1) + (size_t)(l * 3) * INW, p.q_norm_g + l * 64, p.k_norm_g + l * 64, (const float*)(ws + WS_ROPE), QB, KB, VB, UP, UC};
                pg8::gemm_phase<EpiInProj, InProjOrderB, true, true>(lds, g, S, E);
                asm volatile("s_waitcnt vmcnt(0)" ::: "memory");
                __syncthreads();
                if (threadIdx.x == 0) {
                    int ntile = 0; for (int i = 0; i * G + bx < IPB_N; ++i) ++ntile;
                    __builtin_amdgcn_fence(__ATOMIC_RELEASE, "agent"); asm volatile("s_waitcnt vmcnt(0)" ::: "memory");
                    __hip_atomic_fetch_add(cntw, (unsigned)ntile, __ATOMIC_RELAXED, __HIP_MEMORY_SCOPE_AGENT);
                }
            }
            const float lam = ((const float*)(ws + WS_LAM))[l];
            const float post = 1.f - (0.8f - 0.6f * expf(-0.3f * (float)l));
            for (int u = bx; u < 512; u += G) attn_unit(lds, QB, KB, VB, MIX, (u & 7) >> 2, u & 3, CTXL + (u >> 3) * 128, lam, post, p.subln_g + l * 128);
            const int nrt = (last ? MLAT : MALL) / 64;
            const int nca = last ? 0 : 16;
            const int NE = nca + 2 * nrt;
            const bool part = bx >= nlate;
            if (part) {
                if (threadIdx.x == 0) {
                    unsigned sp = 0;
                    while (__hip_atomic_load(cntw, __ATOMIC_RELAXED, __HIP_MEMORY_SCOPE_AGENT) < (unsigned)IPB_N) { __builtin_amdgcn_s_sleep(2); if (++sp > (1u << 22)) break; }
                    __builtin_amdgcn_fence(__ATOMIC_ACQUIRE, "agent"); asm volatile("s_waitcnt vmcnt(0)" ::: "memory");
                }
                __syncthreads();
            }
            for (int e = bx - nlate; part && e < NE; e += G - nlate) {
                if (e < nca) attn_unit(lds, QB, KB, VB, MIX, e >> 3, (e >> 1) & 3, (e & 1) * 128, lam, post, p.subln_g + l * 128);
                else if (e < nca + nrt) conv_unit(lds, UC, p.conv_w + (size_t)l * 31 * 256, p.conv_b + l * 256, p.conv_ln_g + l * 256, p.conv_ln_b + l * 256, MIX, (e - nca) * 64);
                else pool_unit(lds, UP, p.pool_w + (size_t)l * 4 * 64 * 64, p.pool_scale + l * 256, MIX, (e - nca - nrt) * 64);
            }
        }
        GRID_BAR();
        const int Mrows = last ? MLAT : MALL;
        {
            PH_WS();
            pg8::Gemm g{MIX, (const bf16_t*)(wl + W_OUT), MLAT, DM, DM}; pg8::StaticOrder S; S.init(MLAT, DM, G, bx);
            EpiResid E{l == 0 ? p.x : p.out, l == 0 ? p.ctx : XC, p.out, XC, modl + 2 * DM, p.norm2_g + l * DM, modl + 4 * DM, XG, rs2};
            pg8::gemm_phase<EpiResid, pg8::StaticOrder, true, true>(lds, g, S, E);
            if (!last) for (int blk = bx; blk < 256; blk += G)
                ctx_slice_gemm(lds, MIX, (const bf16_t*)(wl + W_OUT), DM, l == 0 ? p.ctx : XC, XC, modl + 2 * 6144 + 2 * DM, p.norm2_g + l * DM, modl + 2 * 6144 + 4 * DM, XG, rs2, blk);
        }
        GRID_BAR();
        {
            PH_WS();
            pg8::Gemm g{XG, (const bf16_t*)(wl + W_FI), Mrows, FFI, DM}; pg8::StaticOrder S; S.init(Mrows, FFI, G, bx);
            EpiSwiGLU E{rs2, (const float*)(ws + Z_BIAS2) + (size_t)(l * 3) * FFI, ACT};
            pg8::gemm_phase<EpiSwiGLU, pg8::StaticOrder, true, true>(lds, g, S, E);
            if (!last) {
                const int nwg = (Mrows / 256) * (FFI / 256), rounds = (nwg + G - 1) / G; int nbusy = nwg - (rounds - 1) * G; if (nbusy >= G) nbusy = 0;
                if (bx >= nbusy) { int t_l = threadIdx.x; asm volatile("" : "+v"(t_l)); bias_layer(p, l + 1, (bx - nbusy) * 8 + (t_l >> 6), (G - nbusy) * 8, t_l & 63); }
            }
        }
        GRID_BAR();
        {
            PH_WS();
            pg8::Gemm g{ACT, (const bf16_t*)(wl + W_FO), MLAT, DM, FFH}; pg8::StaticOrder S; S.init(MLAT, DM, G, bx);
            EpiResid E{p.out, XC, p.out, XC, modl + 5 * DM, last ? nullptr : p.norm1_g + (l + 1) * DM, modl + 3 * 6144 + 1 * DM, XG, ROWSQ + (size_t)(2 * (l + 1)) * MALL};
            pg8::gemm_phase<EpiResid, pg8::StaticOrder, true, true>(lds, g, S, E);
            if (!last) for (int blk = bx; blk < 256; blk += G)
                ctx_slice_gemm(lds, ACT, (const bf16_t*)(wl + W_FO), FFH, XC, XC, modl + 2 * 6144 + 5 * DM, p.norm1_g + (l + 1) * DM, modl + 3 * 6144 + 2 * 6144 + 1 * DM, XG, ROWSQ + (size_t)(2 * (l + 1)) * MALL, blk);
        }
        if (!last) GRID_BAR();
    }
}
#undef MOD
#undef ROWSQ
#undef XG
#undef QB
#undef KB
#undef VB
#undef UP
#undef UC
#undef MIX
#undef ACT
#undef XC
#undef wl
#undef modl
#undef rs1
#undef rs2

extern "C" void kernel_launch(void* const* d_in, const int* in_sizes, int n_in, void* d_out, int out_size, void* d_ws, size_t ws_size, hipStream_t stream) {
    static int grid = 0;
    if (grid == 0) {
        if (n_in != 25 || out_size != MLAT * DM || ws_size < WS_END) { fprintf(stderr, "kernel_launch: unexpected shapes (n_in %d out %d ws %zu)\n", n_in, out_size, ws_size); grid = -1; return; }
        int dev = 0, cus = 0, per_cu = 0;
        hipGetDevice(&dev);
        hipDeviceGetAttribute(&cus, hipDeviceAttributeMultiprocessorCount, dev);
        hipFuncSetAttribute((const void*)fwd_megakernel, hipFuncAttributeMaxDynamicSharedMemorySize, LDS_BYTES);
        hipOccupancyMaxActiveBlocksPerMultiprocessor(&per_cu, (const void*)fwd_megakernel, 512, LDS_BYTES);
        if (per_cu < 1 || cus < 1) { fprintf(stderr, "kernel_launch: occupancy query %d x %d\n", per_cu, cus); grid = -1; return; }
        grid = cus;
        (void)hipGetLastError();
    }
    if (grid < 0) return;
    hipMemsetAsync(d_ws, 0, ZERO_BYTES, stream);
    Params p{};
    const float** pp = (const float**)&p;
    for (int i = 0; i < 25; ++i) pp[i] = (const float*)d_in[i];
    p.out = (float*)d_out; p.ws = (unsigned char*)d_ws;
    void* args[] = {&p};
    hipError_t e = hipLaunchCooperativeKernel((const void*)fwd_megakernel, dim3(grid), dim3(512), args, LDS_BYTES, stream);
    if (e != hipSuccess) fprintf(stderr, "cooperative launch failed: %s (grid %d)\n", hipGetErrorString(e), grid);
}
```

```cpp
#include <hip/hip_runtime.h>
#include <hip/hip_cooperative_groups.h>
#include <cstdio>
#include <cstdint>
namespace cg = cooperative_groups;
namespace pg8 {
#define PG8_LAS __attribute__((address_space(3)))
typedef unsigned short bf16_t;
typedef short bf16x8 __attribute__((ext_vector_type(8)));
typedef float f32x4 __attribute__((ext_vector_type(4)));
typedef unsigned u32x4 __attribute__((ext_vector_type(4)));
constexpr int BM = 256, BK = 64, HALF = 128, HTB = HALF * BK * 2  , STAGE_BYTES = 8 * HTB, NXCD = 8, WGM = 8;

__host__ __device__ __forceinline__ int lds_byte(int r, int c) { const int st = (r >> 4) * 2 + (c >> 5), rr = r & 15, cc = c & 31, ob = rr * 64 + cc * 2; return st * 1024 + (ob ^ (((ob >> 9) & 1) << 5)); }
__host__ __device__ __forceinline__ void stage_rc(int b, int& R, int& C) { const int st = b / 1024, sb = b % 1024, swz = sb ^ (((sb >> 9) & 1) << 5); R = (st >> 1) * 16 + swz / 64; C = (st & 1) * 32 + (swz % 64) / 2; }
__host__ __device__ __forceinline__ int perm32(int rho) { const int n = rho >> 4, i = rho & 15; return 8 * (i >> 2) + 4 * n + (i & 3); }

struct Unit { int pm, pn; };
struct Gemm { const bf16_t* A; const bf16_t* Bt; int M, N, K; };

struct StaticOrder {
    int nM, nN, nwg, G, c;
    __host__ __device__ void init(int M, int N, int G_, int c_) { nM = M / BM; nN = N / BM; nwg = nM * nN; G = G_; c = c_; }
    __host__ __device__ bool next(int i, Unit& u) const {
        const long L = (long)i * G + c; if (L >= nwg) return false;
        int wgid = (int)L; { const int q = nwg / NXCD, r = nwg % NXCD, xcd = wgid % NXCD, off = wgid / NXCD; wgid = (xcd < r ? xcd * (q + 1) : r * (q + 1) + (xcd - r) * q) + off; }
        const int nig = WGM * nN, gid = wgid / nig, fm = gid * WGM, gsz = (nM - fm) < WGM ? (nM - fm) : WGM;
        u.pm = fm + ((wgid % nig) % gsz); u.pn = (wgid % nig) / gsz; return true;
    }
    __device__ __forceinline__ void a_ready(const Unit&) const {}
    __device__ __forceinline__ void done(const Unit&) const {}
};

__device__ __forceinline__ unsigned cvt_pk_bf16(float lo, float hi) { unsigned r; asm volatile("v_cvt_pk_bf16_f32 %0, %1, %2" : "=v"(r) : "v"(lo), "v"(hi)); return r; }
typedef float f32x2 __attribute__((ext_vector_type(2)));
template <class Epi, class Sched, bool ALIGN_EPI = false, bool SP2 = false>
__device__ __forceinline__ void gemm_phase(PG8_LAS unsigned char* lds, const Gemm g, const Sched& S, const Epi& E) {
    int tid_l = threadIdx.x; asm volatile("" : "+v"(tid_l)); const int tid = tid_l, wid = __builtin_amdgcn_readfirstlane(tid >> 6), lane = tid & 63, wr = wid >> 2, wc = wid & 3, fr = lane & 15, fq = lane >> 4;
    const int K = g.K, nt = K / BK;
    unsigned voffA[2], voffB[2];
#pragma unroll
    for (int i = 0; i < 2; ++i) { int R, C; stage_rc(tid * 16 + i * 8192, R, C); const int Rb = Epi::PERM ? ((R & ~31) + perm32(R & 31)) : R;
        voffA[i] = (unsigned)(R * K + C) * 2u; voffB[i] = (unsigned)(Rb * K + C) * 2u; }
    const size_t kstep = (size_t)(BK * 2);
    const size_t hstep = (size_t)HALF * K * 2;
    const size_t tstep = 2 * hstep;
    const unsigned ldsw = (unsigned)wid * 1024u;
    const int aoff = lds_byte(wr * 64 + fr, fq * 8), boff = lds_byte(wc * 32 + fr, fq * 8);
#define PG8_SA(b, h) (((b) * 2 + (h)) * HTB)
#define PG8_SB(b, h) ((4 + (b) * 2 + (h)) * HTB)
#define PG8_STAGE(bufoff, gbase, voff) do { _Pragma("unroll") for (int _i = 0; _i < 2; ++_i) \
        __builtin_amdgcn_global_load_lds((const unsigned*)((const char*)(gbase) + (voff)[_i]), (PG8_LAS unsigned*)(lds + (bufoff) + ldsw + _i * 8192), 16, 0, 0); } while (0)
#define PG8_LDA(dst, b, h) do { _Pragma("unroll") for (int m = 0; m < 4; ++m) _Pragma("unroll") for (int k = 0; k < 2; ++k) dst[m][k] = *(const PG8_LAS bf16x8*)(lds + PG8_SA(b, h) + aoff + m * 2048 + k * 1024); } while (0)
#define PG8_LDB(dst, b, h) do { _Pragma("unroll") for (int n = 0; n < 2; ++n) _Pragma("unroll") for (int k = 0; k < 2; ++k) dst[n][k] = *(const PG8_LAS bf16x8*)(lds + PG8_SB(b, h) + boff + n * 2048 + k * 1024); } while (0)
#define PG8_MMA(ai, bj, At, Bt) do { __builtin_amdgcn_s_setprio(1); _Pragma("unroll") for (int m = 0; m < 4; ++m) _Pragma("unroll") for (int n = 0; n < 2; ++n) _Pragma("unroll") for (int k = 0; k < 2; ++k) \
        acc[ai][bj][m][n] = __builtin_amdgcn_mfma_f32_16x16x32_bf16(Bt[n][k], At[m][k], acc[ai][bj][m][n], 0, 0, 0); __builtin_amdgcn_s_setprio(0); } while (0)
#define PG8_WAIT_V(n) asm volatile("s_waitcnt vmcnt(" #n ")" ::: "memory")
#define PG8_WAIT_L(n) asm volatile("s_waitcnt lgkmcnt(" #n ")" ::: "memory")
#define PG8_BAR __builtin_amdgcn_s_barrier()
#define PG8_SCHED __builtin_amdgcn_sched_barrier(0)
    Unit cur, nxt; int ui = 0;
    if (!S.next(0, cur)) return;
    f32x4 acc[2][2][4][2];
#pragma unroll
    for (int a = 0; a < 2; ++a)
#pragma unroll
        for (int b = 0; b < 2; ++b)
#pragma unroll
            for (int m = 0; m < 4; ++m)
#pragma unroll
                for (int n = 0; n < 2; ++n) acc[a][b][m][n] = (f32x4){0.f, 0.f, 0.f, 0.f};
    bf16x8 At[4][2], B0[2][2], B1[2][2];
    const char* cA = (const char*)g.A + (size_t)cur.pm * tstep; const char* cB = (const char*)g.Bt + (size_t)cur.pn * tstep;
    S.a_ready(cur);
    if constexpr (SP2) {
        PG8_STAGE(PG8_SB(0, 0), cB, voffB); PG8_STAGE(PG8_SB(0, 1), cB + hstep, voffB); PG8_STAGE(PG8_SA(0, 0), cA, voffA); PG8_STAGE(PG8_SA(0, 1), cA + hstep, voffA);
        if (wr == 1) PG8_BAR;
        PG8_WAIT_V(2); PG8_BAR;
        PG8_STAGE(PG8_SB(1, 0), cB + kstep, voffB); PG8_STAGE(PG8_SA(1, 0), cA + kstep, voffA); PG8_STAGE(PG8_SB(1, 1), cB + hstep + kstep, voffB);
        PG8_WAIT_V(6); PG8_BAR;
    } else {
        PG8_STAGE(PG8_SB(0, 0), cB, voffB); PG8_STAGE(PG8_SA(0, 0), cA, voffA); PG8_STAGE(PG8_SB(0, 1), cB + hstep, voffB); PG8_STAGE(PG8_SA(0, 1), cA + hstep, voffA);
        if (wr == 1) PG8_BAR;
        PG8_WAIT_V(4); PG8_BAR;
        PG8_STAGE(PG8_SB(1, 0), cB + kstep, voffB); PG8_STAGE(PG8_SA(1, 0), cA + kstep, voffA); PG8_STAGE(PG8_SB(1, 1), cB + hstep + kstep, voffB);
        PG8_WAIT_V(6); PG8_BAR;
    }
    for (;;) {
        const bool has_next = S.next(ui + 1, nxt);
        const char* nA = has_next ? (const char*)g.A + (size_t)nxt.pm * tstep : cA; const char* nB = has_next ? (const char*)g.Bt + (size_t)nxt.pn * tstep : cB;
        for (int t = 0; t < nt; t += 2) {
            const bool last = (t == nt - 2);
            const char* a1 = cA + (size_t)(t + 1) * kstep;
            const char* a2 = last ? nA : cA + (size_t)(t + 2) * kstep; const char* b2 = last ? nB : cB + (size_t)(t + 2) * kstep;
            const char* a3 = a2 + kstep; const char* b3 = b2 + kstep;
            if (last && has_next) S.a_ready(nxt);
            if constexpr (SP2) {
            PG8_LDB(B0, 0, 0); PG8_LDB(B1, 0, 1); PG8_SCHED; PG8_LDA(At, 0, 0); PG8_STAGE(PG8_SA(1, 1), a1 + hstep, voffA);
            PG8_WAIT_V(8); PG8_WAIT_L(0); PG8_BAR; PG8_MMA(0, 0, At, B0); PG8_MMA(0, 1, At, B1); PG8_BAR; PG8_SCHED;
            PG8_LDA(At, 0, 1); PG8_STAGE(PG8_SB(0, 0), b2, voffB); PG8_STAGE(PG8_SB(0, 1), b2 + hstep, voffB); PG8_STAGE(PG8_SA(0, 0), a2, voffA);
            PG8_WAIT_V(8); PG8_WAIT_L(0); PG8_BAR; PG8_MMA(1, 0, At, B0); PG8_MMA(1, 1, At, B1); PG8_BAR; PG8_SCHED;
            PG8_LDB(B0, 1, 0); PG8_LDB(B1, 1, 1); PG8_SCHED; PG8_LDA(At, 1, 0); PG8_STAGE(PG8_SA(0, 1), a2 + hstep, voffA);
            PG8_WAIT_V(8); PG8_WAIT_L(0); PG8_BAR; PG8_MMA(0, 0, At, B0); PG8_MMA(0, 1, At, B1); PG8_BAR; PG8_SCHED;
            PG8_LDA(At, 1, 1); PG8_STAGE(PG8_SB(1, 0), b3, voffB); PG8_STAGE(PG8_SB(1, 1), b3 + hstep, voffB); PG8_STAGE(PG8_SA(1, 0), a3, voffA);
            PG8_WAIT_V(8); PG8_WAIT_L(0); PG8_BAR; PG8_MMA(1, 0, At, B0); PG8_MMA(1, 1, At, B1); PG8_BAR; PG8_SCHED;
            } else {
            PG8_LDB(B0, 0, 0); PG8_SCHED; PG8_LDA(At, 0, 0); PG8_STAGE(PG8_SA(1, 1), a1 + hstep, voffA);
            PG8_WAIT_L(8); PG8_BAR; PG8_WAIT_L(0); PG8_MMA(0, 0, At, B0); PG8_BAR; PG8_SCHED;
            PG8_LDB(B1, 0, 1); PG8_STAGE(PG8_SB(0, 0), b2, voffB);
            PG8_BAR; PG8_WAIT_L(0); PG8_MMA(0, 1, At, B1); PG8_BAR;
            PG8_LDA(At, 0, 1); PG8_STAGE(PG8_SA(0, 0), a2, voffA);
            PG8_BAR; PG8_WAIT_L(0); PG8_MMA(1, 0, At, B0); PG8_BAR; PG8_SCHED;
            PG8_STAGE(PG8_SB(0, 1), b2 + hstep, voffB);
            PG8_WAIT_V(6); PG8_BAR; PG8_MMA(1, 1, At, B1); PG8_BAR;
            PG8_LDB(B0, 1, 0); PG8_SCHED; PG8_LDA(At, 1, 0); PG8_STAGE(PG8_SA(0, 1), a2 + hstep, voffA);
            PG8_WAIT_L(8); PG8_BAR; PG8_WAIT_L(0); PG8_MMA(0, 0, At, B0); PG8_BAR; PG8_SCHED;
            PG8_LDB(B1, 1, 1); PG8_STAGE(PG8_SB(1, 0), b3, voffB);
            PG8_BAR; PG8_WAIT_L(0); PG8_MMA(0, 1, At, B1); PG8_BAR;
            PG8_LDA(At, 1, 1); PG8_STAGE(PG8_SA(1, 0), a3, voffA);
            PG8_BAR; PG8_WAIT_L(0); PG8_MMA(1, 0, At, B0); PG8_BAR; PG8_SCHED;
            PG8_STAGE(PG8_SB(1, 1), b3 + hstep, voffB);
            PG8_WAIT_V(6); PG8_BAR; PG8_MMA(1, 1, At, B1); PG8_BAR;
            }
        }
        if constexpr (ALIGN_EPI) { if (wr == 0) PG8_BAR; }
        if constexpr (!Epi::AFTER_DRAIN) { E(acc, cur, wr, wc, fr, fq); S.done(cur); }
        if (!has_next) break;
#pragma unroll
        for (int a = 0; a < 2; ++a)
#pragma unroll
            for (int b = 0; b < 2; ++b)
#pragma unroll
                for (int m = 0; m < 4; ++m)
#pragma unroll
                    for (int n = 0; n < 2; ++n) acc[a][b][m][n] = (f32x4){0.f, 0.f, 0.f, 0.f};
        cur = nxt; cA = nA; cB = nB; ++ui;
        if constexpr (ALIGN_EPI) { if (wr == 1) PG8_BAR; }
    }
    PG8_WAIT_V(0);
    if constexpr (!ALIGN_EPI) { if (wr == 0) PG8_BAR; }
    PG8_BAR;
    if constexpr (Epi::AFTER_DRAIN) { E.fused(acc, cur, wr, wc, fr, fq, lds, wid, lane); S.done(cur); }
#undef PG8_SA
#undef PG8_SB
#undef PG8_STAGE
#undef PG8_LDA
#undef PG8_LDB
#undef PG8_MMA
#undef PG8_WAIT_V
#undef PG8_WAIT_L
#undef PG8_BAR
#undef PG8_SCHED
}
}
#define LAS __attribute__((address_space(3)))
#define XB_TMO      128
#define XB_XCNT(j)  (256  + 64 * (j))
#define XB_XSUB(j)  (1280 + 64 * (j))
#define XB_XGEN(j)  (2304 + 64 * (j))
#define XB_TOP      3328
#define XB_TOPGEN   3392
#define XCD_BAR_WORDS 3456
#define XB_SPIN_CAP (1u << 18)

__device__ __forceinline__ unsigned xb_ld(unsigned* p)              { return __hip_atomic_load(p, __ATOMIC_RELAXED, __HIP_MEMORY_SCOPE_AGENT); }
__device__ __forceinline__ unsigned xb_add(unsigned* p, unsigned v) { return __hip_atomic_fetch_add(p, v, __ATOMIC_RELAXED, __HIP_MEMORY_SCOPE_AGENT); }
__device__ __forceinline__ unsigned xb_xcc_id() { return (unsigned)__builtin_amdgcn_s_getreg((3 << 11) | 20) & 0xFu; }
#define XB_SPIN(cond, bar) do { unsigned _sp = 0; while (cond) { __builtin_amdgcn_s_sleep(1); \
    if ((++_sp & 255u) == 0u) { if (xb_ld(&(bar)[XB_TMO])) break; if (_sp > XB_SPIN_CAP) { atomicAdd(&(bar)[XB_TMO], 1u); break; } } } } while (0)

struct XcdBarrier {
    unsigned* bar; unsigned x;
    volatile LAS unsigned* st;
};

__device__ __forceinline__ XcdBarrier xcd_barrier_post(unsigned* bar, volatile LAS unsigned* st) {
    XcdBarrier b; b.bar = bar; b.x = xb_xcc_id(); b.st = st;
    if (threadIdx.x == 0) (void)xb_add(&bar[XB_XCNT(b.x)], 1u);
    return b;
}
__device__ __forceinline__ void xcd_barrier_complete(unsigned* bar, unsigned x, unsigned& nloc, unsigned& nx) {
    const unsigned G = gridDim.x * gridDim.y * gridDim.z;
    unsigned sum, cnt, mine, sp = 0u;
    for (;;) {
        sum = 0u; cnt = 0u; mine = 0u;
#pragma unroll
        for (unsigned j = 0; j < 16; ++j) { const unsigned c = xb_ld(&bar[XB_XCNT(j)]); sum += c; cnt += (c > 0u) ? 1u : 0u; mine = (j == x) ? c : mine; }
        if (sum == G) break;
        __builtin_amdgcn_s_sleep(1);
        if ((++sp & 255u) == 0u) { if (xb_ld(&bar[XB_TMO])) break; if (sp > XB_SPIN_CAP) { atomicAdd(&bar[XB_TMO], 1u); break; } }
    }
    nloc = mine > 0u ? mine : 1u; nx = cnt > 0u ? cnt : 1u;
}

__device__ __forceinline__ void xcd_barrier(const XcdBarrier& b) {
    asm volatile("s_waitcnt vmcnt(0)" ::: "memory");
    __syncthreads();
    if (threadIdx.x == 0) {
        unsigned* bar = b.bar;
        __builtin_amdgcn_s_waitcnt(0);
        unsigned nloc = b.st[0], nx = b.st[1];
        if (nloc == 0u) { xcd_barrier_complete(bar, b.x, nloc, nx); b.st[0] = nloc; b.st[1] = nx; }
        const unsigned old = xb_add(&bar[XB_XSUB(b.x)], 1u);
        const unsigned gen = old / nloc;
        if (old + 1u == (gen + 1u) * nloc) {
            __builtin_amdgcn_fence(__ATOMIC_RELEASE, "agent");
            asm volatile("s_waitcnt vmcnt(0)" ::: "memory");
            const unsigned og = xb_add(&bar[XB_TOP], 1u);
            const unsigned tg = og / nx;
            if (og + 1u == (tg + 1u) * nx) xb_add(&bar[XB_TOPGEN], 1u);
            else XB_SPIN(xb_ld(&bar[XB_TOPGEN]) == tg, bar);
            __builtin_amdgcn_fence(__ATOMIC_ACQUIRE, "agent");
            xb_add(&bar[XB_XGEN(b.x)], 1u);
            asm volatile("s_waitcnt vmcnt(0)" ::: "memory");
        } else {
            XB_SPIN(xb_ld(&bar[XB_XGEN(b.x)]) == gen, bar);
            __builtin_amdgcn_fence(__ATOMIC_ACQUIRE, "agent");
            asm volatile("s_waitcnt vmcnt(0)" ::: "memory");
        }
    }
    __syncthreads();
}

using pg8::bf16_t; using pg8::bf16x8; using pg8::f32x4; using pg8::u32x4; using pg8::Unit;
typedef float f32x16 __attribute__((ext_vector_type(16)));
typedef unsigned u32x2 __attribute__((ext_vector_type(2)));
typedef short s16x4 __attribute__((ext_vector_type(4)));
#define LAS __attribute__((address_space(3)))

constexpr int DM = 1024, NB = 2, SEQ = 8192, DEPTH = 4, CTXL = 256;
constexpr int MLAT = NB * SEQ, MCTX = NB * CTXL, MALL = MLAT + MCTX;
constexpr int INW = 2304, FFH = 2816, FFI = 5632;
constexpr int LK = SEQ + CTXL, NTK = LK / 64;
constexpr float EPSN = 1e-6f;
constexpr float QSCALE = 0.125f * 1.4426950408889634f;

constexpr size_t MiB = 1u << 20;
constexpr size_t ZERO_BYTES = 2 * MiB;
constexpr size_t Z_MOD = 0, Z_BIAS1 = 294912, Z_BIAS2 = 405504, Z_ROWSQ = 675840;
constexpr size_t Z_CNT = 1600000;
constexpr size_t Z_BAR = 1572864;
static_assert(Z_ROWSQ + (size_t)8 * MALL * 4 <= Z_BAR && Z_BAR + XCD_BAR_WORDS * 4 <= Z_CNT && Z_CNT + 4 * 256 <= ZERO_BYTES, "zero region");
constexpr size_t WS_ROPE = 2 * MiB, WS_LAM = 2 * MiB + 16384;
constexpr size_t WS_W = 4 * MiB, W_LAYER = 25 * MiB, W_IN = 0, W_OUT = 4718592, W_FI = 6815744, W_FO = 18350080;
constexpr size_t WS_XG = 104 * MiB, WS_Q = 140 * MiB, WS_K = 157 * MiB, WS_V = 174 * MiB, WS_UP = 191 * MiB, WS_UC = 208 * MiB, WS_MIX = 225 * MiB;
constexpr size_t WS_ACT = 140 * MiB, WS_XC = 259 * MiB, WS_END = 262 * MiB;
constexpr int LDS_BYTES = 147456;

struct Params {
    const float *x, *c, *ctx, *c_ctx, *w_mod, *b_mod, *norm1_g, *w_in, *q_norm_g, *k_norm_g, *lq1, *lk1, *lq2, *lk2, *subln_g, *pool_w, *pool_scale,
                *conv_w, *conv_b, *conv_ln_g, *conv_ln_b, *w_out, *norm2_g, *w_ffn_in, *w_ffn_out;
    float* out; unsigned char* ws;
};

__device__ __forceinline__ float wave_sum(float v) {
#pragma unroll
    for (int o = 1; o < 64; o <<= 1) v += __shfl_xor(v, o);
    return v;
}
__device__ __forceinline__ float sigm(float v) { return __builtin_amdgcn_rcpf(1.f + __builtin_amdgcn_exp2f(-1.4426950408889634f * v)); }
__device__ __forceinline__ float siluf(float v) { return v * sigm(v); }
__device__ __forceinline__ unsigned pkbf(float lo, float hi) { return pg8::cvt_pk_bf16(lo, hi); }

__device__ __forceinline__ int perm_in(int cn) {
    const int pn = cn >> 8, pos = cn & 255;
    if (pn < 4) { const int bj = pos >> 7, wc = (pos >> 5) & 3, e = pos & 31; return pn * 256 + wc * 64 + bj * 32 + e; }
    if (pn < 7) return cn;
    return (pos < 128) ? (1792 + 128 * (pn - 7) + pos) : (2048 + 128 * (pn - 7) + pos - 128);
}
__device__ __forceinline__ int perm_fi(int cn) { const int pn = cn >> 8, pos = cn & 255; return (pos < 128) ? (128 * pn + pos) : (FFH + 128 * pn + pos - 128); }

__device__ __forceinline__ int voff(int row, int ch) { return 2048 * (row >> 3) + 512 * (ch >> 2) + 64 * (row & 7) + 16 * ((ch & 3) ^ ((row >> 2) & 3)); }

struct EpiInProj {
    static constexpr bool PERM = true, AFTER_DRAIN = false;
    const float* rowsq; const float* bias; const float* qg; const float* kg; const float* rope;
    bf16_t* Qb; bf16_t* Kb; bf16_t* Vb; float* upool; float* uconv;
    __device__ __forceinline__ void operator()(const f32x4 (&acc)[2][2][4][2], const Unit& u, int wr, int wc, int fr, int fq) const {
        const int pn = u.pn, pm = u.pm;
        const bool isctx = pm >= 64;
        const int v = isctx ? 2 : (pm >> 5);
        const int cb = pn * 256 + wc * 32 + 8 * fq;
        f32x4 bv[2][2];
#pragma unroll
        for (int bj = 0; bj < 2; ++bj)
#pragma unroll
            for (int n = 0; n < 2; ++n) bv[bj][n] = *(const f32x4*)(bias + v * INW + cb + 128 * bj + 4 * n);
        if (pn < 4) {
            const bool isq = pn < 2;
            const float* gp = isq ? qg : kg;
            f32x4 gv[2][2];
#pragma unroll
            for (int bj = 0; bj < 2; ++bj)
#pragma unroll
                for (int n = 0; n < 2; ++n) gv[bj][n] = *(const f32x4*)(gp + 32 * bj + 8 * fq + 4 * n);
            const int hc = (isq ? pn : pn - 2) * 4 + wc;
            bf16_t* dst = isq ? Qb : Kb;
            const float osc = isq ? QSCALE : 1.f;
#pragma unroll
            for (int ai = 0; ai < 2; ++ai)
#pragma unroll
                for (int m = 0; m < 4; ++m) {
                    const int row = pm * 256 + ai * 128 + wr * 64 + m * 16 + fr;
                    const float rinv = rsqrtf(rowsq[row] * (1.f / DM) + EPSN);
                    int b, kidx, t = 0;
                    if (isctx) { const int rc = row - MLAT; b = rc >> 8; kidx = rc & 255; } else { b = row >> 13; t = row & (SEQ - 1); kidx = CTXL + t; }
                    f32x4 val[2][2]; float ss = 0.f;
#pragma unroll
                    for (int bj = 0; bj < 2; ++bj)
#pragma unroll
                        for (int n = 0; n < 2; ++n) { val[bj][n] = acc[ai][bj][m][n] * rinv + bv[bj][n]; const f32x4 q = val[bj][n]; ss += (q[0] * q[0] + q[1] * q[1]) + (q[2] * q[2] + q[3] * q[3]); }
                    ss += __shfl_xor(ss, 16); ss += __shfl_xor(ss, 32);
                    const float rn = rsqrtf(ss * (1.f / 64.f) + EPSN);
#pragma unroll
                    for (int bj = 0; bj < 2; ++bj) {
                        f32x4 y0 = val[bj][0] * rn * gv[bj][0], y1 = val[bj][1] * rn * gv[bj][1];
                        if (!isctx) {
                            const int pos = bj == 0 ? (t >> 6) : (t & 63);
                            const f32x4 r0 = *(const f32x4*)(rope + (size_t)(pos * 16 + 4 * fq) * 2);
                            const f32x4 r1 = *(const f32x4*)(rope + (size_t)(pos * 16 + 4 * fq + 2) * 2);
                            f32x4 z0, z1;
                            z0[0] = y0[0] * r0[0] - y0[1] * r0[1]; z0[1] = y0[0] * r0[1] + y0[1] * r0[0];
                            z0[2] = y0[2] * r0[2] - y0[3] * r0[3]; z0[3] = y0[2] * r0[3] + y0[3] * r0[2];
                            z1[0] = y1[0] * r1[0] - y1[1] * r1[1]; z1[1] = y1[0] * r1[1] + y1[1] * r1[0];
                            z1[2] = y1[2] * r1[2] - y1[3] * r1[3]; z1[3] = y1[2] * r1[3] + y1[3] * r1[2];
                            y0 = z0; y1 = z1;
                        }
                        y0 = y0 * osc; y1 = y1 * osc;
                        u32x4 w; w.x = pkbf(y0[0], y0[1]); w.y = pkbf(y0[2], y0[3]); w.z = pkbf(y1[0], y1[1]); w.w = pkbf(y1[2], y1[3]);
                        const size_t off = (size_t)(b * 8 + hc) * (LK * 64) + (size_t)(kidx >> 6) * 4096 + (size_t)(4 * bj + fq) * 512 + (size_t)(kidx & 63) * 8;
                        *(u32x4*)(dst + off) = w;
                    }
                }
        } else if (pn < 6) {
#pragma unroll
            for (int ai = 0; ai < 2; ++ai)
#pragma unroll
                for (int m = 0; m < 4; ++m) {
                    const int row = pm * 256 + ai * 128 + wr * 64 + m * 16 + fr;
                    const float rinv = rsqrtf(rowsq[row] * (1.f / DM) + EPSN);
                    int b, kidx;
                    if (isctx) { const int rc = row - MLAT; b = rc >> 8; kidx = rc & 255; } else { b = row >> 13; kidx = CTXL + (row & (SEQ - 1)); }
#pragma unroll
                    for (int bj = 0; bj < 2; ++bj) {
                        const f32x4 y0 = acc[ai][bj][m][0] * rinv + bv[bj][0], y1 = acc[ai][bj][m][1] * rinv + bv[bj][1];
                        u32x4 w; w.x = pkbf(y0[0], y0[1]); w.y = pkbf(y0[2], y0[3]); w.z = pkbf(y1[0], y1[1]); w.w = pkbf(y1[2], y1[3]);
                        const int head = 2 * (pn - 4) + bj;
                        const size_t off = (size_t)(b * 4 + head) * (LK * 128) + (size_t)(kidx >> 6) * 8192 + (size_t)(voff(kidx & 63, 4 * wc + fq) >> 1);
                        *(u32x4*)(Vb + off) = w;
                    }
                }
        } else if (pn == 6) {
#pragma unroll
            for (int ai = 0; ai < 2; ++ai)
#pragma unroll
                for (int m = 0; m < 4; ++m) {
                    const int row = pm * 256 + ai * 128 + wr * 64 + m * 16 + fr;
                    const float rinv = rsqrtf(rowsq[row] * (1.f / DM) + EPSN);
#pragma unroll
                    for (int bj = 0; bj < 2; ++bj)
#pragma unroll
                        for (int n = 0; n < 2; ++n) *(f32x4*)(upool + (size_t)row * 256 + 128 * bj + 32 * wc + 8 * fq + 4 * n) = acc[ai][bj][m][n] * rinv + bv[bj][n];
                }
        } else {
            const int ch0 = 128 * (pn - 7) + 32 * wc + 8 * fq;
#pragma unroll
            for (int ai = 0; ai < 2; ++ai)
#pragma unroll
                for (int m = 0; m < 4; ++m) {
                    const int row = pm * 256 + ai * 128 + wr * 64 + m * 16 + fr;
                    const float rinv = rsqrtf(rowsq[row] * (1.f / DM) + EPSN);
#pragma unroll
                    for (int n = 0; n < 2; ++n) {
                        const f32x4 a = acc[ai][0][m][n] * rinv + bv[0][n], g = acc[ai][1][m][n] * rinv + bv[1][n];
                        f32x4 o;
#pragma unroll
                        for (int j = 0; j < 4; ++j) o[j] = a[j] * sigm(g[j]);
                        *(f32x4*)(uconv + (size_t)row * 256 + ch0 + 4 * n) = o;
                    }
                }
        }
    }
};

struct EpiResid {
    static constexpr bool PERM = true, AFTER_DRAIN = false;
    const float* res_lat; const float* res_ctx; float* dst_lat; float* dst_ctx;
    const float* gate;
    const float* ng;
    const float* nsc;
    bf16_t* xg; float* rowsq_next;
    __device__ __forceinline__ void operator()(const f32x4 (&acc)[2][2][4][2], const Unit& u, int wr, int wc, int fr, int fq) const {
        const int pn = u.pn, pm = u.pm;
        const bool isctx = pm >= 64;
        const int v = isctx ? 2 : (pm >> 5);
        const int cb = pn * 256 + wc * 32 + 8 * fq;
        const bool nxt = ng != nullptr;
        f32x4 gt[2][2], gs[2][2];
#pragma unroll
        for (int bj = 0; bj < 2; ++bj)
#pragma unroll
            for (int n = 0; n < 2; ++n) {
                const int col = cb + 128 * bj + 4 * n;
                gt[bj][n] = *(const f32x4*)(gate + v * 6144 + col);
                if (nxt) { const f32x4 a = *(const f32x4*)(ng + col), s = *(const f32x4*)(nsc + v * 6144 + col); gs[bj][n] = a * (s + 1.f); } else gs[bj][n] = (f32x4){0.f, 0.f, 0.f, 0.f};
            }
#pragma unroll
        for (int q2 = 0; q2 < 4; ++q2) {
            const int ai = q2 >> 1, m0 = (q2 & 1) * 2;
            f32x4 pre[2][2][2];
#pragma unroll
            for (int mm = 0; mm < 2; ++mm) {
                const int row = pm * 256 + ai * 128 + wr * 64 + (m0 + mm) * 16 + fr;
                const float* src = isctx ? res_ctx + (size_t)(row - MLAT) * DM : res_lat + (size_t)row * DM;
#pragma unroll
                for (int bj = 0; bj < 2; ++bj) { pre[mm][bj][0] = *(const f32x4*)(src + cb + 128 * bj); pre[mm][bj][1] = *(const f32x4*)(src + cb + 128 * bj + 4); }
            }
#pragma unroll
            for (int mm = 0; mm < 2; ++mm) {
                const int m = m0 + mm;
                const int row = pm * 256 + ai * 128 + wr * 64 + m * 16 + fr;
                float* dst = isctx ? dst_ctx + (size_t)(row - MLAT) * DM : dst_lat + (size_t)row * DM;
                float ss = 0.f;
#pragma unroll
                for (int bj = 0; bj < 2; ++bj) {
                    const int col = cb + 128 * bj;
                    const f32x4 x0 = pre[mm][bj][0] + gt[bj][0] * acc[ai][bj][m][0];
                    const f32x4 x1 = pre[mm][bj][1] + gt[bj][1] * acc[ai][bj][m][1];
                    *(f32x4*)(dst + col) = x0; *(f32x4*)(dst + col + 4) = x1;
                    if (nxt) {
                        ss += (x0[0] * x0[0] + x0[1] * x0[1]) + (x0[2] * x0[2] + x0[3] * x0[3]) + (x1[0] * x1[0] + x1[1] * x1[1]) + (x1[2] * x1[2] + x1[3] * x1[3]);
                        const f32x4 y0 = x0 * gs[bj][0], y1 = x1 * gs[bj][1];
                        u32x4 w; w.x = pkbf(y0[0], y0[1]); w.y = pkbf(y0[2], y0[3]); w.z = pkbf(y1[0], y1[1]); w.w = pkbf(y1[2], y1[3]);
                        *(u32x4*)(xg + (size_t)row * DM + col) = w;
                    }
                }
                if (nxt) { ss += __shfl_xor(ss, 16); ss += __shfl_xor(ss, 32); if (fq == 0) unsafeAtomicAdd(rowsq_next + row, ss); }
            }
        }
    }
};

struct EpiSwiGLU {
    static constexpr bool PERM = true, AFTER_DRAIN = false;
    const float* rowsq; const float* bias; bf16_t* act;
    __device__ __forceinline__ void operator()(const f32x4 (&acc)[2][2][4][2], const Unit& u, int wr, int wc, int fr, int fq) const {
        const int pn = u.pn, pm = u.pm;
        const int v = pm >= 64 ? 2 : (pm >> 5);
        const int cb = pn * 256 + wc * 32 + 8 * fq;
        f32x4 bv[2][2];
#pragma unroll
        for (int bj = 0; bj < 2; ++bj)
#pragma unroll
            for (int n = 0; n < 2; ++n) bv[bj][n] = *(const f32x4*)(bias + v * FFI + cb + 128 * bj + 4 * n);
#pragma unroll
        for (int ai = 0; ai < 2; ++ai)
#pragma unroll
            for (int m = 0; m < 4; ++m) {
                const int row = pm * 256 + ai * 128 + wr * 64 + m * 16 + fr;
                const float rinv = rsqrtf(rowsq[row] * (1.f / DM) + EPSN);
                f32x4 o[2];
#pragma unroll
                for (int n = 0; n < 2; ++n) {
                    const f32x4 g = acc[ai][0][m][n] * rinv + bv[0][n], up = acc[ai][1][m][n] * rinv + bv[1][n];
#pragma unroll
                    for (int j = 0; j < 4; ++j) o[n][j] = g[j] * sigm(g[j]) * up[j];
                }
                u32x4 w; w.x = pkbf(o[0][0], o[0][1]); w.y = pkbf(o[0][2], o[0][3]); w.z = pkbf(o[1][0], o[1][1]); w.w = pkbf(o[1][2], o[1][3]);
                *(u32x4*)(act + (size_t)row * FFH + pn * 128 + wc * 32 + 8 * fq) = w;
            }
    }
};

#define AT_WAITV(n) asm volatile("s_waitcnt vmcnt(" #n ")" ::: "memory")
__device__ __forceinline__ void glds16(const void* gsrc, unsigned lds_dst) { unsigned keep;
    asm volatile("s_mov_b32 %0, m0\n\ts_mov_b32 m0, %2\n\ts_nop 0\n\tglobal_load_lds_dwordx4 %1, off\n\ts_mov_b32 m0, %0" : "=&s"(keep) : "v"(gsrc), "s"(lds_dst) : "memory"); }
__device__ __forceinline__ void glds16s(unsigned voff, const void* sbase, unsigned lds_dst) { unsigned keep;
    asm volatile("s_mov_b32 %0, m0\n\ts_mov_b32 m0, %3\n\ts_nop 0\n\tglobal_load_lds_dwordx4 %1, %2\n\ts_mov_b32 m0, %0" : "=&s"(keep) : "v"(voff), "s"(sbase), "s"(lds_dst) : "memory"); }
__device__ __forceinline__ s16x4 tr16(const LAS unsigned char* p) { return __builtin_bit_cast(s16x4, __builtin_amdgcn_ds_read_tr16_b64_v4i16((LAS s16x4*)p)); }

#define AT_SB() __builtin_amdgcn_sched_barrier(0)
__device__ __forceinline__ float fadd_s(float a, float b) { float r; asm("v_add_f32_e32 %0, %1, %2" : "=v"(r) : "v"(a), "v"(b)); return r; }
#define AT_WAIT_BAR(N) asm volatile("s_waitcnt vmcnt(" #N ") lgkmcnt(0)\n\ts_barrier" ::: "memory")
__device__ __forceinline__ void attn_unit(LAS unsigned char* lds, const bf16_t* Qb, const bf16_t* Kb, const bf16_t* Vb, bf16_t* mix,
                                          int b, int head, int qbase  , float lam, float post_scale, const float* subg) {
    int tid_l = threadIdx.x; asm volatile("" : "+v"(tid_l)); const int tid = tid_l, lane = tid & 63, wid = __builtin_amdgcn_readfirstlane(tid >> 6);
    const int r = lane & 31, h = lane >> 5;
    const int qg = wid & 3, c = wid >> 2;
    const int NT = qbase < CTXL ? (CTXL / 64) : NTK;
    const int qidx = qbase + qg * 32 + r;
    const size_t bh = (size_t)(b * 4 + head);
    const bf16_t* Qc = Qb + (bh * 2 + c) * (LK * 64);
    const unsigned char* K0 = (const unsigned char*)(Kb + (bh * 2) * (LK * 64));
    const unsigned char* V0 = (const unsigned char*)(Vb + bh * (LK * 128));
    const unsigned goff = (unsigned)(wid * 1024 + lane * 16);
    const unsigned ldsb = (unsigned)(size_t)lds;
    constexpr int VRING = 65536;
#define AT_DMA_K(t, slot) do { const unsigned _d = (unsigned)__builtin_amdgcn_readfirstlane((int)(ldsb + (unsigned)((slot) * 16384 + wid * 1024))); \
        glds16s(goff, K0 + (size_t)(t) * 8192, _d); glds16s(goff, K0 + (size_t)(LK * 128) + (size_t)(t) * 8192, _d + 8192u); } while (0)
#define AT_DMA_V(t, slot) do { const unsigned _d = (unsigned)__builtin_amdgcn_readfirstlane((int)(ldsb + (unsigned)(VRING + (slot) * 16384 + wid * 1024))); \
        glds16s(goff, V0 + (size_t)(t) * 16384, _d); glds16s(goff, V0 + (size_t)(t) * 16384 + 8192, _d + 8192u); } while (0)
    AT_DMA_K(0, 0); AT_DMA_V(0, 0); AT_DMA_K(1, 1);
    bf16x8 q[4];
#pragma unroll
    for (int d0 = 0; d0 < 4; ++d0) q[d0] = *(const bf16x8*)(Qc + (size_t)(qidx >> 6) * 4096 + (size_t)(2 * d0 + h) * 512 + (size_t)(qidx & 63) * 8);
    AT_DMA_K(2, 2);
    f32x16 O[4];
#pragma unroll
    for (int d = 0; d < 4; ++d)
#pragma unroll
        for (int i = 0; i < 16; ++i) O[d][i] = 0.f;
    float lsum = 0.f;
    const int koff = c * 8192 + h * 1024 + r * 16;
    const int g1 = (lane >> 4) & 1, qq = (lane & 15) >> 2, pp = lane & 3;
    const int vlo = VRING + 64 * (4 * h + qq) + 16 * (2 * g1 + ((pp >> 1) ^ h)) + 8 * (pp & 1);
    const int vhi = VRING + 2048 + 64 * (4 * h + qq) + 16 * (2 * (g1 ^ 1) + ((pp >> 1) ^ h)) + 8 * (pp & 1);
    bf16x8 kf[8];
#define AT_KLOAD2(j, slot) do { kf[2 * (j)] = *(const LAS bf16x8*)(lds + (slot) * 16384 + koff + (j) * 2048); kf[2 * (j) + 1] = *(const LAS bf16x8*)(lds + (slot) * 16384 + koff + (j) * 2048 + 512); } while (0)
#define AT_VFRAG(dst, vp, n) do { const s16x4 lo_ = tr16((vp) + vlo + ((n) >> 2) * 4096 + ((n) & 3) * 512), hi_ = tr16((vp) + vhi + ((n) >> 2) * 4096 + ((n) & 3) * 512); \
        dst = (bf16x8){lo_[0], lo_[1], lo_[2], lo_[3], hi_[0], hi_[1], hi_[2], hi_[3]}; } while (0)
    f32x16 pA0, pA1, pB0, pB1;
    u32x4 pw0, pw1, pw2, pw3;
    const f32x16 zero16 = {0.f, 0.f, 0.f, 0.f, 0.f, 0.f, 0.f, 0.f, 0.f, 0.f, 0.f, 0.f, 0.f, 0.f, 0.f, 0.f};
    int sl_prev = 0, sl_cur = 0, sl_next = 1;
#define AT_ROT() do { sl_prev = sl_cur; sl_cur = sl_next; sl_next = (sl_next == 2) ? 0 : sl_next + 1; } while (0)
    AT_WAIT_BAR(6);
    AT_KLOAD2(0, 0); AT_KLOAD2(1, 0); AT_KLOAD2(2, 0); AT_KLOAD2(3, 0);
    pA0 = __builtin_amdgcn_mfma_f32_32x32x16_bf16(kf[0], q[0], zero16, 0, 0, 0); pA1 = __builtin_amdgcn_mfma_f32_32x32x16_bf16(kf[1], q[0], zero16, 0, 0, 0);
#pragma unroll
    for (int d0 = 1; d0 < 4; ++d0) { pA0 = __builtin_amdgcn_mfma_f32_32x32x16_bf16(kf[2 * d0], q[d0], pA0, 0, 0, 0); pA1 = __builtin_amdgcn_mfma_f32_32x32x16_bf16(kf[2 * d0 + 1], q[d0], pA1, 0, 0, 0); }
#pragma unroll
    for (int i = 0; i < 16; ++i) { pA0[i] = __builtin_amdgcn_exp2f(pA0[i]); pA1[i] = __builtin_amdgcn_exp2f(pA1[i]); }
    AT_WAIT_BAR(0);
    AT_DMA_K(3, 3); AT_DMA_V(1, 1);
    AT_ROT();
    AT_KLOAD2(0, 1); AT_KLOAD2(1, 1);
    AT_WAIT_BAR(4);
#define AT_PK(P, B) pkbf(P[B], P[B + 1])
#define AT_GAPA(MF, P, B, PW, X, Y) do { MF; sacc = fadd_s(sacc, P[B]); sacc = fadd_s(sacc, P[B + 1]); sacc = fadd_s(sacc, P[B + 2]); sacc = fadd_s(sacc, P[B + 3]); PW.X = AT_PK(P, B); PW.Y = AT_PK(P, B + 2); AT_SB(); } while (0)
#define AT_GAPB(n, C, B) do { if ((n) + 2 < 16) AT_VFRAG(vfr[((n) + 2) % 3], vp_, (n) + 2); \
        O[(n) & 3] = __builtin_amdgcn_mfma_f32_32x32x16_bf16(vfr[(n) % 3], __builtin_bit_cast(bf16x8, pwv[(n) >> 2]), O[(n) & 3], 0, 0, 0); \
        C[B] = __builtin_amdgcn_exp2f(C[B]); C[B + 1] = __builtin_amdgcn_exp2f(C[B + 1]); AT_SB(); } while (0)
#define AT_STEP(C0, C1, P0, P1, t, GK, GV, GL) do { AT_SB(); \
        const LAS unsigned char* vp_ = lds + sl_prev * 16384; float sacc = 0.f; \
        AT_KLOAD2(2, (t) & 3); AT_KLOAD2(3, (t) & 3); AT_SB(); \
        AT_GAPA(C0 = __builtin_amdgcn_mfma_f32_32x32x16_bf16(kf[0], q[0], zero16, 0, 0, 0), P0, 0, pw0, x, y); \
        AT_GAPA(C1 = __builtin_amdgcn_mfma_f32_32x32x16_bf16(kf[1], q[0], zero16, 0, 0, 0), P0, 4, pw0, z, w); \
        AT_GAPA(C0 = __builtin_amdgcn_mfma_f32_32x32x16_bf16(kf[2], q[1], C0, 0, 0, 0), P0, 8, pw1, x, y); \
        AT_GAPA(C1 = __builtin_amdgcn_mfma_f32_32x32x16_bf16(kf[3], q[1], C1, 0, 0, 0), P0, 12, pw1, z, w); \
        AT_GAPA(C0 = __builtin_amdgcn_mfma_f32_32x32x16_bf16(kf[4], q[2], C0, 0, 0, 0), P1, 0, pw2, x, y); \
        AT_GAPA(C1 = __builtin_amdgcn_mfma_f32_32x32x16_bf16(kf[5], q[2], C1, 0, 0, 0), P1, 4, pw2, z, w); \
        bf16x8 vfr[3]; AT_VFRAG(vfr[0], vp_, 0); AT_VFRAG(vfr[1], vp_, 1); AT_SB(); \
        AT_GAPA(C0 = __builtin_amdgcn_mfma_f32_32x32x16_bf16(kf[6], q[3], C0, 0, 0, 0), P1, 8, pw3, x, y); \
        AT_GAPA(C1 = __builtin_amdgcn_mfma_f32_32x32x16_bf16(kf[7], q[3], C1, 0, 0, 0), P1, 12, pw3, z, w); \
        lsum += sacc; \
        if (GK) AT_DMA_K((t) + 3, ((t) + 3) & 3); if (GV) AT_DMA_V((t) + 1, sl_next); \
        const u32x4 pwv[4] = {pw0, pw1, pw2, pw3}; AT_SB(); \
        AT_GAPB(0, C0, 0); AT_GAPB(1, C0, 2); AT_GAPB(2, C0, 4); AT_GAPB(3, C0, 6); \
        if (GL) { AT_KLOAD2(0, ((t) + 1) & 3); AT_SB(); } AT_GAPB(4, C0, 8); \
        if (GL) { AT_KLOAD2(1, ((t) + 1) & 3); AT_SB(); } AT_GAPB(5, C0, 10); \
        AT_GAPB(6, C0, 12); AT_GAPB(7, C0, 14); \
        AT_GAPB(8, C1, 0); AT_GAPB(9, C1, 2); AT_GAPB(10, C1, 4); AT_GAPB(11, C1, 6); AT_GAPB(12, C1, 8); AT_GAPB(13, C1, 10); AT_GAPB(14, C1, 12); AT_GAPB(15, C1, 14); \
    } while (0)
#define AT_ENDW(tt) do { if ((tt) + 3 < NT) { AT_WAIT_BAR(4); } else if ((tt) + 2 < NT) { AT_WAIT_BAR(2); } else { AT_WAIT_BAR(0); } } while (0)
    int t = 1;
    for (; t + 5 < NT; t += 2) {
        AT_STEP(pB0, pB1, pA0, pA1, t, true, true, true);     AT_WAIT_BAR(4); AT_ROT();
        AT_STEP(pA0, pA1, pB0, pB1, t + 1, true, true, true); AT_WAIT_BAR(4); AT_ROT();
    }
    for (; t + 1 < NT; t += 2) {
        AT_STEP(pB0, pB1, pA0, pA1, t, (t + 3 < NT), (t + 1 < NT), (t + 1 < NT));         AT_ENDW(t);     AT_ROT();
        AT_STEP(pA0, pA1, pB0, pB1, t + 1, (t + 4 < NT), (t + 2 < NT), (t + 2 < NT));     AT_ENDW(t + 1); AT_ROT();
    }
    AT_STEP(pB0, pB1, pA0, pA1, NT - 1, false, false, false);
    {
        float sacc = 0.f;
#pragma unroll
        for (int i = 0; i < 16; ++i) sacc += pB0[i] + pB1[i];
        lsum += sacc;
        pw0 = (u32x4){AT_PK(pB0, 0), AT_PK(pB0, 2), AT_PK(pB0, 4), AT_PK(pB0, 6)}; pw1 = (u32x4){AT_PK(pB0, 8), AT_PK(pB0, 10), AT_PK(pB0, 12), AT_PK(pB0, 14)};
        pw2 = (u32x4){AT_PK(pB1, 0), AT_PK(pB1, 2), AT_PK(pB1, 4), AT_PK(pB1, 6)}; pw3 = (u32x4){AT_PK(pB1, 8), AT_PK(pB1, 10), AT_PK(pB1, 12), AT_PK(pB1, 14)};
        const u32x4 pwv[4] = {pw0, pw1, pw2, pw3};
        const LAS unsigned char* vp_ = lds + sl_cur * 16384;
#pragma unroll
        for (int n = 0; n < 16; ++n) { bf16x8 vf_; AT_VFRAG(vf_, vp_, n); O[n & 3] = __builtin_amdgcn_mfma_f32_32x32x16_bf16(vf_, __builtin_bit_cast(bf16x8, pwv[n >> 2]), O[n & 3], 0, 0, 0); }
    }
#undef AT_STEP
#undef AT_GAPA
#undef AT_GAPB
#undef AT_ENDW
#undef AT_PK
#undef AT_ROT
#undef AT_KLOAD2
#undef AT_VFRAG
#undef AT_DMA_K
#undef AT_DMA_V
    asm volatile("s_waitcnt vmcnt(0) lgkmcnt(0)" ::: "memory");
    __builtin_amdgcn_s_barrier();
    asm volatile("" ::: "memory");
    const float lt = lsum + __shfl_xor(lsum, 32);
    int tid_e = threadIdx.x; asm volatile("" : "+v"(tid_e));
    const int lane_e = tid_e & 63, h_e = lane_e >> 5, qidx_e = qbase + qg * 32 + (lane_e & 31);
    LAS float* X = (LAS float*)lds + qg * 4096 + lane_e;
    if (c == 1) {
        const float sc = lam / lt;
#pragma unroll
        for (int d = 0; d < 4; ++d)
#pragma unroll
            for (int i = 0; i < 16; ++i) X[(d * 16 + i) * 64] = O[d][i] * sc;
    }
    asm volatile("s_waitcnt lgkmcnt(0)" ::: "memory");
    __builtin_amdgcn_s_barrier();
    asm volatile("" ::: "memory");
    if (c == 0) {
        const float i0 = 1.f / lt;
        float ss = 0.f;
#pragma unroll
        for (int d = 0; d < 4; ++d)
#pragma unroll
            for (int i = 0; i < 16; ++i) { const float o = O[d][i] * i0 - X[(d * 16 + i) * 64]; O[d][i] = o; ss += o * o; }
        ss += __shfl_xor(ss, 32);
        const float rn = rsqrtf(ss * (1.f / 128.f) + EPSN) * post_scale;
        const int qrow = qbase < CTXL ? (MLAT + b * CTXL + qidx_e) : (b * SEQ + qidx_e - CTXL);
        bf16_t* orow = mix + (size_t)qrow * DM + head * 128;
#pragma unroll
        for (int d = 0; d < 4; ++d)
#pragma unroll
            for (int i4 = 0; i4 < 4; ++i4) {
                const int dv = 32 * d + 8 * i4 + 4 * h_e;
                const f32x4 g = *(const f32x4*)(subg + dv);
                u32x2 w; w.x = pkbf(O[d][4 * i4] * rn * g[0], O[d][4 * i4 + 1] * rn * g[1]); w.y = pkbf(O[d][4 * i4 + 2] * rn * g[2], O[d][4 * i4 + 3] * rn * g[3]);
                *(u32x2*)(orow + dv) = w;
            }
    }
    asm volatile("s_waitcnt vmcnt(0) lgkmcnt(0)" ::: "memory");
    __builtin_amdgcn_s_barrier();
    asm volatile("" ::: "memory");
}

constexpr int PPITCH = 260;
template <int W> __device__ __forceinline__ void pool_win(const float* up, int seq0, int L, int tfirst, int ch, LAS float* Pout) {
    constexpr int LO = W / 2, HI = W - W / 2, NV = 31 + W;
    float u[NV];
#pragma unroll
    for (int j = 0; j < NV; ++j) { const int tt = tfirst - LO + j; u[j] = (tt >= 0 && tt < L) ? up[(size_t)(seq0 + tt) * 256 + ch] : 0.f; }
    float c[NV + 1]; c[0] = 0.f;
#pragma unroll
    for (int j = 0; j < NV; ++j) c[j + 1] = c[j] + u[j];
#pragma unroll
    for (int i = 0; i < 32; ++i) {
        const int t = tfirst + i; int lo = t - LO, hi = t + HI; lo = lo < 0 ? 0 : lo; hi = hi > L ? L : hi;
        Pout[i * PPITCH] = (c[i + W] - c[i]) * __builtin_amdgcn_rcpf((float)(hi - lo)) - u[i + LO];
    }
}
__device__ __forceinline__ void pool_unit(LAS unsigned char* lds, const float* upool, const float* pw  , const float* pscale, bf16_t* mix, int row0) {
    int tid_l = threadIdx.x; asm volatile("" : "+v"(tid_l)); const int tid = tid_l, lane = tid & 63, wid = __builtin_amdgcn_readfirstlane(tid >> 6);
    LAS float* P = (LAS float*)lds;
    int seq0, L;
    if (row0 < MLAT) { seq0 = row0 & ~(SEQ - 1); L = SEQ; } else { seq0 = MLAT + ((row0 - MLAT) & ~(CTXL - 1)); L = CTXL; }
    const int g = wid & 3, half = wid >> 2;
    {
        const int ch = g * 64 + lane, tfirst = row0 - seq0 + half * 32;
        LAS float* Pout = P + (half * 32) * PPITCH + ch;
        if (g == 0) pool_win<2>(upool, seq0, L, tfirst, ch, Pout);
        else if (g == 1) pool_win<4>(upool, seq0, L, tfirst, ch, Pout);
        else if (g == 2) pool_win<8>(upool, seq0, L, tfirst, ch, Pout);
        else pool_win<16>(upool, seq0, L, tfirst, ch, Pout);
    }
    const int r = lane & 31, h = lane >> 5;
    bf16x8 bw[4][2];
#pragma unroll
    for (int ks = 0; ks < 4; ++ks)
#pragma unroll
        for (int nt = 0; nt < 2; ++nt) {
            const float* wp = pw + (size_t)(g * 64 + 16 * ks + 8 * h) * 64 + 32 * nt + r;
            u32x4 w; w.x = pkbf(wp[0], wp[64]); w.y = pkbf(wp[128], wp[192]); w.z = pkbf(wp[256], wp[320]); w.w = pkbf(wp[384], wp[448]);
            bw[ks][nt] = __builtin_bit_cast(bf16x8, w);
        }
    const float sc0 = pscale[g * 64 + r], sc1 = pscale[g * 64 + 32 + r];
    __syncthreads();
    {
        f32x16 d0, d1;
#pragma unroll
        for (int i = 0; i < 16; ++i) { d0[i] = 0.f; d1[i] = 0.f; }
        const LAS float* pa = P + (half * 32 + r) * PPITCH + g * 64 + 8 * h;
#pragma unroll
        for (int ks = 0; ks < 4; ++ks) {
            const f32x4 a0 = *(const LAS f32x4*)(pa + 16 * ks), a1 = *(const LAS f32x4*)(pa + 16 * ks + 4);
            u32x4 w; w.x = pkbf(a0[0], a0[1]); w.y = pkbf(a0[2], a0[3]); w.z = pkbf(a1[0], a1[1]); w.w = pkbf(a1[2], a1[3]);
            const bf16x8 af = __builtin_bit_cast(bf16x8, w);
            d0 = __builtin_amdgcn_mfma_f32_32x32x16_bf16(af, bw[ks][0], d0, 0, 0, 0);
            d1 = __builtin_amdgcn_mfma_f32_32x32x16_bf16(af, bw[ks][1], d1, 0, 0, 0);
        }
        bf16_t* ob = mix + (size_t)(row0 + half * 32) * DM + 512 + g * 64 + r;
#pragma unroll
        for (int i = 0; i < 16; ++i) {
            const int tk = (i & 3) + 8 * (i >> 2) + 4 * h;
            const unsigned bits = pkbf(d0[i] * sc0, d1[i] * sc1);
            ob[(size_t)tk * DM] = (bf16_t)(bits & 0xffffu);
            ob[(size_t)tk * DM + 32] = (bf16_t)(bits >> 16);
        }
    }
    __syncthreads();
}

__device__ __forceinline__ void conv_unit(LAS unsigned char* lds, const float* uconv, const float* cw  , const float* cb, const float* lng, const float* lnb, bf16_t* mix, int row0) {
    int tid_l = threadIdx.x; asm volatile("" : "+v"(tid_l)); const int tid = tid_l, lane = tid & 63, wid = tid >> 6;
    LAS float* Y = (LAS float*)lds;
    int seq0, L;
    if (row0 < MLAT) { seq0 = row0 & ~(SEQ - 1); L = SEQ; } else { seq0 = MLAT + ((row0 - MLAT) & ~(CTXL - 1)); L = CTXL; }
    {
        const int ch = tid & 255, half = tid >> 8;
        const int t0 = row0 - seq0 + half * 32;
        float uwin[62];
#pragma unroll
        for (int j = 0; j < 62; ++j) { const int tt = t0 - 15 + j; uwin[j] = (tt >= 0 && tt < L) ? uconv[(size_t)(seq0 + tt) * 256 + ch] : 0.f; }
        float w[31];
#pragma unroll
        for (int j = 0; j < 31; ++j) w[j] = cw[j * 256 + ch];
        const float bias = cb[ch];
#pragma unroll
        for (int i = 0; i < 32; ++i) {
            float a = bias;
#pragma unroll
            for (int j = 0; j < 31; ++j) a += uwin[i + j] * w[j];
            Y[(half * 32 + i) * 256 + ch] = a;
        }
    }
    __syncthreads();
    {
        const f32x4 g4 = *(const f32x4*)(lng + 4 * lane), b4 = *(const f32x4*)(lnb + 4 * lane);
        f32x4 y[8]; float s1[8], s2[8];
#pragma unroll
        for (int i = 0; i < 8; ++i) {
            y[i] = *(const LAS f32x4*)(Y + (wid * 8 + i) * 256 + 4 * lane);
            s1[i] = (y[i][0] + y[i][1]) + (y[i][2] + y[i][3]);
            s2[i] = (y[i][0] * y[i][0] + y[i][1] * y[i][1]) + (y[i][2] * y[i][2] + y[i][3] * y[i][3]);
        }
#pragma unroll
        for (int o = 1; o < 64; o <<= 1)
#pragma unroll
            for (int i = 0; i < 8; ++i) { s1[i] += __shfl_xor(s1[i], o); s2[i] += __shfl_xor(s2[i], o); }
#pragma unroll
        for (int i = 0; i < 8; ++i) {
            const int tk = wid * 8 + i;
            const float mu = s1[i] * (1.f / 256.f);
            const float var = fmaxf(s2[i] * (1.f / 256.f) - mu * mu, 0.f);
            const float rs = rsqrtf(var + EPSN);
            f32x4 z = (y[i] - mu) * rs * g4 + b4;
#pragma unroll
            for (int j = 0; j < 4; ++j) z[j] = z[j] * sigm(z[j]);
            u32x2 w; w.x = pkbf(z[0], z[1]); w.y = pkbf(z[2], z[3]);
            *(u32x2*)(mix + (size_t)(row0 + tk) * DM + 768 + 4 * lane) = w;
        }
    }
    __syncthreads();
}

__device__ __forceinline__ void ctx_slice_gemm(LAS unsigned char* lds, const bf16_t* A  , const bf16_t* Bt  , int K,
                                               const float* res_ctx, float* dst_ctx, const float* gate2  , const float* ng, const float* nsc2  ,
                                               bf16_t* xg, float* rowsq_next, int blk) {
    int tid_l = threadIdx.x; asm volatile("" : "+v"(tid_l)); const int tid = tid_l, lane = tid & 63, wid = __builtin_amdgcn_readfirstlane(tid >> 6), r16 = lane & 15, g4 = lane >> 4;
    const int row0 = (blk >> 5) * 64, col0 = (blk & 31) * 32;
    const int kw = K >> 3, kbeg = wid * kw;
    const bf16_t* ap = A + (size_t)(MLAT + row0 + r16) * K + kbeg + 8 * g4;
    const bf16_t* bp = Bt + (size_t)(col0 + r16) * K + kbeg + 8 * g4;
    const size_t a16 = (size_t)16 * K;
    f32x4 acc[4][2];
#pragma unroll
    for (int i = 0; i < 4; ++i)
#pragma unroll
        for (int j = 0; j < 2; ++j) acc[i][j] = (f32x4){0.f, 0.f, 0.f, 0.f};
#pragma unroll 4
    for (int k = 0; k < kw; k += 32) {
        bf16x8 fa[4], fb[2];
#pragma unroll
        for (int i = 0; i < 4; ++i) fa[i] = *(const bf16x8*)(ap + i * a16 + k);
#pragma unroll
        for (int j = 0; j < 2; ++j) fb[j] = *(const bf16x8*)(bp + j * a16 + k);
#pragma unroll
        for (int i = 0; i < 4; ++i)
#pragma unroll
            for (int j = 0; j < 2; ++j) acc[i][j] = __builtin_amdgcn_mfma_f32_16x16x32_bf16(fa[i], fb[j], acc[i][j], 0, 0, 0);
    }
    LAS float* part = (LAS float*)lds;
#pragma unroll
    for (int i = 0; i < 4; ++i)
#pragma unroll
        for (int j = 0; j < 2; ++j)
#pragma unroll
            for (int q = 0; q < 4; ++q) part[((wid * 8 + i * 2 + j) * 4 + q) * 64 + lane] = acc[i][j][q];
    __syncthreads();
    {
        const int t = wid, rgi = t >> 1, cg = t & 1, col = col0 + 16 * cg + r16;
        const float gt = gate2[col];
        const bool nxt = ng != nullptr;
        const float gs = nxt ? ng[col] * (1.f + nsc2[col]) : 0.f;
#pragma unroll
        for (int q = 0; q < 4; ++q) {
            float s = 0.f;
#pragma unroll
            for (int w = 0; w < 8; ++w) s += part[((w * 8 + t) * 4 + q) * 64 + lane];
            const int rr = row0 + 16 * rgi + 4 * g4 + q;
            const float x = res_ctx[(size_t)rr * DM + col] + gt * s;
            dst_ctx[(size_t)rr * DM + col] = x;
            if (nxt) {
                xg[(size_t)(MLAT + rr) * DM + col] = (bf16_t)(pkbf(x * gs, 0.f) & 0xffffu);
                float ss = x * x;
                ss += __shfl_xor(ss, 1); ss += __shfl_xor(ss, 2); ss += __shfl_xor(ss, 4); ss += __shfl_xor(ss, 8);
                if (r16 == 0) unsafeAtomicAdd(rowsq_next + MLAT + rr, ss);
            }
        }
    }
    __syncthreads();
}

__device__ __forceinline__ void transpose_item(const float* W, int K, int N, bf16_t* WT, int k0, int n_src, int n_dst, LAS float* scr, int lane) {
#pragma unroll 8
    for (int i = 0; i < 32; ++i) { const int kk = 2 * i + (lane >> 5); scr[kk * 33 + (lane & 31)] = W[(size_t)(k0 + kk) * N + n_src + (lane & 31)]; }
    asm volatile("s_waitcnt lgkmcnt(0)" ::: "memory");
    const int c = lane & 7;
#pragma unroll
    for (int j = 0; j < 4; ++j) {
        const int n = (lane >> 3) + 8 * j; const LAS float* s = scr + (8 * c) * 33 + n;
        u32x4 o; o.x = pkbf(s[0 * 33], s[1 * 33]); o.y = pkbf(s[2 * 33], s[3 * 33]); o.z = pkbf(s[4 * 33], s[5 * 33]); o.w = pkbf(s[6 * 33], s[7 * 33]);
        *(u32x4*)(WT + (size_t)(n_dst + n) * K + k0 + 8 * c) = o;
    }
    asm volatile("s_waitcnt lgkmcnt(0)" ::: "memory");
}

__device__ __forceinline__ void convert_layer(const Params& p, LAS unsigned char* lds, int l, int gwi, int ngw, int lane, int wid) {
    LAS float* scr = (LAS float*)(lds + wid * 16384);
    unsigned char* wl = p.ws + WS_W + (size_t)l * W_LAYER;
    for (int it = gwi; it < 5888; it += ngw) {
        int rr = it;
        if (rr < 1152) { const int kb = rr / 72, nb = rr % 72; transpose_item(p.w_in + (size_t)l * DM * INW, DM, INW, (bf16_t*)(wl + W_IN), 64 * kb, perm_in(32 * nb), 32 * nb, scr, lane); continue; } rr -= 1152;
        if (rr < 512) { const int kb = rr / 32, nb = rr % 32; transpose_item(p.w_out + (size_t)l * DM * DM, DM, DM, (bf16_t*)(wl + W_OUT), 64 * kb, 32 * nb, 32 * nb, scr, lane); continue; } rr -= 512;
        if (rr < 2816) { const int kb = rr / 176, nb = rr % 176; transpose_item(p.w_ffn_in + (size_t)l * DM * FFI, DM, FFI, (bf16_t*)(wl + W_FI), 64 * kb, perm_fi(32 * nb), 32 * nb, scr, lane); continue; } rr -= 2816;
        { const int kb = rr / 32, nb = rr % 32; transpose_item(p.w_ffn_out + (size_t)l * FFH * DM, FFH, DM, (bf16_t*)(wl + W_FO), 64 * kb, 32 * nb, 32 * nb, scr, lane); }
    }
}
__device__ __forceinline__ void bias_rows(const bf16_t* Wt, int N, const float* sh  , float* bias  , int gwi, int ngw, int lane) {
    f32x4 s[3][4];
#pragma unroll
    for (int v = 0; v < 3; ++v)
#pragma unroll
        for (int j = 0; j < 4; ++j) s[v][j] = *(const f32x4*)(sh + v * 6144 + (j >> 1) * 512 + 8 * lane + 4 * (j & 1));
    for (int n = gwi; n < N; n += ngw) {
        const u32x4 w0 = *(const u32x4*)(Wt + (size_t)n * DM + 8 * lane), w1 = *(const u32x4*)(Wt + (size_t)n * DM + 512 + 8 * lane);
        float wf[16];
#pragma unroll
        for (int j = 0; j < 4; ++j) { wf[2 * j] = __uint_as_float(w0[j] << 16); wf[2 * j + 1] = __uint_as_float(w0[j] & 0xffff0000u); wf[8 + 2 * j] = __uint_as_float(w1[j] << 16); wf[8 + 2 * j + 1] = __uint_as_float(w1[j] & 0xffff0000u); }
#pragma unroll
        for (int v = 0; v < 3; ++v) {
            float a = 0.f;
#pragma unroll
            for (int j = 0; j < 16; ++j) a += wf[j] * s[v][j >> 2][j & 3];
            a = wave_sum(a);
            if (lane == 0) bias[(size_t)v * N + n] = a;
        }
    }
}
__device__ __forceinline__ void bias_layer(const Params& p, int l, int gwi, int ngw, int lane) {
    unsigned char* ws = p.ws;
    const float* modl = (const float*)(ws + Z_MOD) + (size_t)(l * 3) * 6144;
    const unsigned char* wl = ws + WS_W + (size_t)l * W_LAYER;
    bias_rows((const bf16_t*)(wl + W_IN), INW, modl, (float*)(ws + Z_BIAS1) + (size_t)(l * 3) * INW, gwi, ngw, lane);
    bias_rows((const bf16_t*)(wl + W_FI), FFI, modl + 3 * DM, (float*)(ws + Z_BIAS2) + (size_t)(l * 3) * FFI, gwi, ngw, lane);
}
__device__ __forceinline__ void phase_p0a(const Params& p, LAS unsigned char* lds) {
    int tid_l = threadIdx.x; asm volatile("" : "+v"(tid_l)); const int tid = tid_l, lane = tid & 63, wid = tid >> 6;
    const int G = gridDim.x, gw = blockIdx.x * 8 + wid, NGW = G * 8;
    unsigned char* ws = p.ws;
    float* MOD = (float*)(ws + Z_MOD);
    {
        const int gt = blockIdx.x * 512 + tid;
        if (gt < 2048) { const int pos = gt >> 4, fi = gt & 15; const float inv = powf(10000.f, -(float)fi * (1.f / 16.f)); const float ang = (float)pos * inv;
            float* rp = (float*)(ws + WS_ROPE); rp[2 * gt] = cosf(ang); rp[2 * gt + 1] = sinf(ang); }
        if (gt >= 2048 && gt < 2048 + DEPTH) { const int l = gt - 2048; float s1 = 0.f, s2 = 0.f;
            for (int i = 0; i < 64; ++i) { s1 += p.lq1[l * 64 + i] * p.lk1[l * 64 + i]; s2 += p.lq2[l * 64 + i] * p.lk2[l * 64 + i]; }
            const float li = 0.8f - 0.6f * expf(-0.3f * (float)l);
            ((float*)(ws + WS_LAM))[l] = expf(s1) - expf(s2) + li; }
    }
    for (int it = gw; it < DEPTH * 24 * 16; it += NGW) {
        const int l = it / 384, rem = it % 384, cgp = rem >> 4, kc = rem & 15, col = cgp * 256 + 4 * lane, k0 = kc * 64;
        f32x4 a0 = {0.f, 0.f, 0.f, 0.f}, a1 = a0, a2 = a0;
        const float* W = p.w_mod + ((size_t)l * DM + k0) * 6144 + col;
#pragma unroll 8
        for (int kk = 0; kk < 64; ++kk) {
            const f32x4 w = *(const f32x4*)(W + (size_t)kk * 6144);
            const float s0 = siluf(p.c[k0 + kk]), s1 = siluf(p.c[DM + k0 + kk]), s2 = siluf(p.c_ctx[k0 + kk]);
            a0 += w * s0; a1 += w * s1; a2 += w * s2;
        }
        if (kc == 0) { const f32x4 bm = *(const f32x4*)(p.b_mod + l * 6144 + col); a0 += bm; a1 += bm; a2 += bm; }
        float* d0 = MOD + (size_t)(l * 3) * 6144 + col;
#pragma unroll
        for (int j = 0; j < 4; ++j) { unsafeAtomicAdd(d0 + j, a0[j]); unsafeAtomicAdd(d0 + 6144 + j, a1[j]); unsafeAtomicAdd(d0 + 2 * 6144 + j, a2[j]); }
    }
    for (int l = 0; l < DEPTH; ++l) convert_layer(p, lds, l, gw, NGW, lane, wid);
}

__device__ __forceinline__ void phase_p0b(const Params& p) {
    int tid_l = threadIdx.x; asm volatile("" : "+v"(tid_l)); const int tid = tid_l, lane = tid & 63, wid = tid >> 6;
    const int G = gridDim.x, gw = blockIdx.x * 8 + wid, NGW = G * 8;
    unsigned char* ws = p.ws;
    const float* MOD = (const float*)(ws + Z_MOD);
    bias_layer(p, 0, gw, NGW, lane);
    bf16_t* XG = (bf16_t*)(ws + WS_XG);
    float* rs = (float*)(ws + Z_ROWSQ);
    for (int row0 = gw; row0 < MALL; row0 += 2 * NGW) {
        const int rows[2] = {row0, row0 + NGW};
        f32x4 xv[2][4]; int vv[2];
#pragma unroll
        for (int q = 0; q < 2; ++q) {
            const int row = rows[q] < MALL ? rows[q] : row0;
            const float* src;
            if (row < MLAT) { src = p.x + (size_t)row * DM; vv[q] = row >> 13; } else { src = p.ctx + (size_t)(row - MLAT) * DM; vv[q] = 2; }
#pragma unroll
            for (int j = 0; j < 4; ++j) xv[q][j] = *(const f32x4*)(src + 4 * lane + 256 * j);
        }
#pragma unroll
        for (int q = 0; q < 2; ++q) {
            if (rows[q] >= MALL) continue;
            const int row = rows[q];
            const float* sc = MOD + (size_t)vv[q] * 6144 + DM;
            float ss = 0.f;
#pragma unroll
            for (int j = 0; j < 4; ++j) {
                const int col = 4 * lane + 256 * j;
                const f32x4 x4 = xv[q][j], g = *(const f32x4*)(p.norm1_g + col), s = *(const f32x4*)(sc + col);
                ss += (x4[0] * x4[0] + x4[1] * x4[1]) + (x4[2] * x4[2] + x4[3] * x4[3]);
                const f32x4 y = x4 * g * (s + 1.f);
                u32x2 w; w.x = pkbf(y[0], y[1]); w.y = pkbf(y[2], y[3]);
                *(u32x2*)(XG + (size_t)row * DM + col) = w;
            }
            ss = wave_sum(ss);
            if (lane == 0) rs[row] = ss;
        }
    }
}

constexpr int IPA_QKV = 66 * 6, IPA_N = 512, IPB_N = 66 * 9 - IPA_N;
__device__ __forceinline__ void ip_tail_tile(int a2, Unit& u) { u.pm = a2 / 3; u.pn = 6 + a2 % 3; }
struct InProjOrderA {
    int G, c;
    __device__ bool next(int i, Unit& u) const {
        const int L = i * G + c; if (L >= IPA_N) return false;
        const int a = (L % pg8::NXCD) * (IPA_N / pg8::NXCD) + L / pg8::NXCD;
        if (a < IPA_QKV) { const int gid = a / 48, fm = gid * 8, gsz = (66 - fm) < 8 ? (66 - fm) : 8, w = a % 48; u.pm = fm + w % gsz; u.pn = w / gsz; }
        else ip_tail_tile(a - IPA_QKV, u);
        return true;
    }
    __device__ __forceinline__ void a_ready(const Unit&) const {}
    __device__ __forceinline__ void done(const Unit&) const {}
};
struct InProjOrderB {
    int G, c;
    __device__ bool next(int i, Unit& u) const { const int L = i * G + c; if (L >= IPB_N) return false; ip_tail_tile(IPA_N - IPA_QKV + L, u); return true; }
    __device__ __forceinline__ void a_ready(const Unit&) const {}
    __device__ __forceinline__ void done(const Unit&) const {}
};

__global__ void __launch_bounds__(512, 2) fwd_megakernel(Params p) {
    extern __shared__ __attribute__((aligned(16))) unsigned char lds_raw[];
    LAS unsigned char* lds = (LAS unsigned char*)lds_raw;
    cg::grid_group grid = cg::this_grid();
    const int G = gridDim.x, bx = blockIdx.x;
#define PH_WS() unsigned char* ws = p.ws; asm volatile("" : "+s"(ws))
#define MOD ((const float*)(ws + Z_MOD))
#define ROWSQ ((float*)(ws + Z_ROWSQ))
#define XG ((bf16_t*)(ws + WS_XG))
#define QB ((bf16_t*)(ws + WS_Q))
#define KB ((bf16_t*)(ws + WS_K))
#define VB ((bf16_t*)(ws + WS_V))
#define UP ((float*)(ws + WS_UP))
#define UC ((float*)(ws + WS_UC))
#define MIX ((bf16_t*)(ws + WS_MIX))
#define ACT ((bf16_t*)(ws + WS_ACT))
#define XC ((float*)(ws + WS_XC))
#define wl (ws + WS_W + (size_t)l * W_LAYER)
#define modl (MOD + (size_t)(l * 3) * 6144)
#define rs1 (ROWSQ + (size_t)(2 * l) * MALL)
#define rs2 (ROWSQ + (size_t)(2 * l + 1) * MALL)

    volatile LAS unsigned* bst = (volatile LAS unsigned*)(lds + 131072 + 64);
    if (threadIdx.x < 2) bst[threadIdx.x] = 0u;
    __syncthreads();
    { PH_WS(); (void)xcd_barrier_post((unsigned*)(ws + Z_BAR), bst); }
#define GRID_BAR() do { XcdBarrier xb2_; unsigned* barp_ = (unsigned*)(p.ws + Z_BAR); asm volatile("" : "+s"(barp_)); xb2_.bar = barp_; xb2_.x = xb_xcc_id(); xb2_.st = bst; xcd_barrier(xb2_); } while (0)

    phase_p0a(p, lds);
    grid.sync();
    phase_p0b(p);
    GRID_BAR();

#pragma nounroll
    for (int l = 0; l < DEPTH; ++l) {
        const bool last = l == DEPTH - 1;
        {
            PH_WS();
            pg8::Gemm g{XG, (const bf16_t*)(wl + W_IN), MALL, INW, DM}; const InProjOrderA S{G, bx};
            EpiInProj E{rs1, (const float*)(ws + Z_BIAS1) + (size_t)(l * 3) * INW, p.q_norm_g + l * 64, p.k_norm_g + l * 64, (const float*)(ws + WS_ROPE), QB, KB, VB, UP, UC};
            pg8::gemm_phase<EpiInProj, InProjOrderA, true, true>(lds, g, S, E);
        }
        GRID_BAR();
        {
            PH_WS();
            unsigned* cntw = (unsigned*)(ws + Z_CNT) + 64 * l;
            const int nlate = IPB_N < G ? IPB_N : 0;
            if (bx < IPB_N) {
                pg8::Gemm g{XG, (const bf16_t*)(wl + W_IN), MALL, INW, DM}; const InProjOrderB S{G, bx};
                EpiInProj E{rs1, (const float*)(ws + Z_BIAS1) + (size_t)(l * 3) * INW, p.q_norm_g + l * 64, p.k_norm_g + l * 64, (const float*)(ws + WS_ROPE), QB, KB, VB, UP, UC};
                pg8::gemm_phase<EpiInProj, InProjOrderB, true, true>(lds, g, S, E);
                asm volatile("s_waitcnt vmcnt(0)" ::: "memory");
                __syncthreads();
                if (threadIdx.x == 0) {
                    int ntile = 0; for (int i = 0; i * G + bx < IPB_N; ++i) ++ntile;
                    __builtin_amdgcn_fence(__ATOMIC_RELEASE, "agent"); asm volatile("s_waitcnt vmcnt(0)" ::: "memory");
                    __hip_atomic_fetch_add(cntw, (unsigned)ntile, __ATOMIC_RELAXED, __HIP_MEMORY_SCOPE_AGENT);
                }
            }
            const float lam = ((const float*)(ws + WS_LAM))[l];
            const float post = 1.f - (0.8f - 0.6f * expf(-0.3f * (float)l));
            for (int u = bx; u < 512; u += G) attn_unit(lds, QB, KB, VB, MIX, (u & 7) >> 2, u & 3, CTXL + (u >> 3) * 128, lam, post, p.subln_g + l * 128);
            const int nrt = (last ? MLAT : MALL) / 64;
            const int nca = last ? 0 : 16;
            const int NE = nca + 2 * nrt;
            const bool part = bx >= nlate;
            if (part) {
                if (threadIdx.x == 0) {
                    unsigned sp = 0;
                    while (__hip_atomic_load(cntw, __ATOMIC_RELAXED, __HIP_MEMORY_SCOPE_AGENT) < (unsigned)IPB_N) { __builtin_amdgcn_s_sleep(2); if (++sp > (1u << 22)) break; }
                    __builtin_amdgcn_fence(__ATOMIC_ACQUIRE, "agent"); asm volatile("s_waitcnt vmcnt(0)" ::: "memory");
                }
                __syncthreads();
            }
            for (int e = bx - nlate; part && e < NE; e += G - nlate) {
                if (e < nca) attn_unit(lds, QB, KB, VB, MIX, e >> 3, (e >> 1) & 3, (e & 1) * 128, lam, post, p.subln_g + l * 128);
                else if (e < nca + nrt) conv_unit(lds, UC, p.conv_w + (size_t)l * 31 * 256, p.conv_b + l * 256, p.conv_ln_g + l * 256, p.conv_ln_b + l * 256, MIX, (e - nca) * 64);
                else pool_unit(lds, UP, p.pool_w + (size_t)l * 4 * 64 * 64, p.pool_scale + l * 256, MIX, (e - nca - nrt) * 64);
            }
        }
        GRID_BAR();
        const int Mrows = last ? MLAT : MALL;
        {
            PH_WS();
            pg8::Gemm g{MIX, (const bf16_t*)(wl + W_OUT), MLAT, DM, DM}; pg8::StaticOrder S; S.init(MLAT, DM, G, bx);
            EpiResid E{l == 0 ? p.x : p.out, l == 0 ? p.ctx : XC, p.out, XC, modl + 2 * DM, p.norm2_g + l * DM, modl + 4 * DM, XG, rs2};
            pg8::gemm_phase<EpiResid, pg8::StaticOrder, true, true>(lds, g, S, E);
            if (!last) for (int blk = bx; blk < 256; blk += G)
                ctx_slice_gemm(lds, MIX, (const bf16_t*)(wl + W_OUT), DM, l == 0 ? p.ctx : XC, XC, modl + 2 * 6144 + 2 * DM, p.norm2_g + l * DM, modl + 2 * 6144 + 4 * DM, XG, rs2, blk);
        }
        GRID_BAR();
        {
            PH_WS();
            pg8::Gemm g{XG, (const bf16_t*)(wl + W_FI), Mrows, FFI, DM}; pg8::StaticOrder S; S.init(Mrows, FFI, G, bx);
            EpiSwiGLU E{rs2, (const float*)(ws + Z_BIAS2) + (size_t)(l * 3) * FFI, ACT};
            pg8::gemm_phase<EpiSwiGLU, pg8::StaticOrder, true, true>(lds, g, S, E);
            if (!last) {
                const int nwg = (Mrows / 256) * (FFI / 256), rounds = (nwg + G - 1) / G; int nbusy = nwg - (rounds - 1) * G; if (nbusy >= G) nbusy = 0;
                if (bx >= nbusy) { int t_l = threadIdx.x; asm volatile("" : "+v"(t_l)); bias_layer(p, l + 1, (bx - nbusy) * 8 + (t_l >> 6), (G - nbusy) * 8, t_l & 63); }
            }
        }
        GRID_BAR();
        {
            PH_WS();
            pg8::Gemm g{ACT, (const bf16_t*)(wl + W_FO), MLAT, DM, FFH}; pg8::StaticOrder S; S.init(MLAT, DM, G, bx);
            EpiResid E{p.out, XC, p.out, XC, modl + 5 * DM, last ? nullptr : p.norm1_g + (l + 1) * DM, modl + 3 * 6144 + 1 * DM, XG, ROWSQ + (size_t)(2 * (l + 1)) * MALL};
            pg8::gemm_phase<EpiResid, pg8::StaticOrder, true, true>(lds, g, S, E);
            if (!last) for (int blk = bx; blk < 256; blk += G)
                ctx_slice_gemm(lds, ACT, (const bf16_t*)(wl + W_FO), FFH, XC, XC, modl + 2 * 6144 + 5 * DM, p.norm1_g + (l + 1) * DM, modl + 3 * 6144 + 2 * 6144 + 1 * DM, XG, ROWSQ + (size_t)(2 * (l + 1)) * MALL, blk);
        }
        if (!last) GRID_BAR();
    }
}
#undef MOD
#undef ROWSQ
#undef XG
#undef QB
#undef KB
#undef VB
#undef UP
#undef UC
#undef MIX
#undef ACT
#undef XC
#undef wl
#undef modl
#undef rs1
#undef rs2

extern "C" void kernel_launch(void* const* d_in, const int* in_sizes, int n_in, void* d_out, int out_size, void* d_ws, size_t ws_size, hipStream_t stream) {
    static int grid = 0;
    if (grid == 0) {
        if (n_in != 25 || out_size != MLAT * DM || ws_size < WS_END) { fprintf(stderr, "kernel_launch: unexpected shapes (n_in %d out %d ws %zu)\n", n_in, out_size, ws_size); grid = -1; return; }
        int dev = 0, cus = 0, per_cu = 0;
        hipGetDevice(&dev);
        hipDeviceGetAttribute(&cus, hipDeviceAttributeMultiprocessorCount, dev);
        hipFuncSetAttribute((const void*)fwd_megakernel, hipFuncAttributeMaxDynamicSharedMemorySize, LDS_BYTES);
        hipOccupancyMaxActiveBlocksPerMultiprocessor(&per_cu, (const void*)fwd_megakernel, 512, LDS_BYTES);
        if (per_cu < 1 || cus < 1) { fprintf(stderr, "kernel_launch: occupancy query %d x %d\n", per_cu, cus); grid = -1; return; }
        grid = cus;
        (void)hipGetLastError();
    }
    if (grid < 0) return;
    hipMemsetAsync(d_ws, 0, ZERO_BYTES, stream);
    Params p{};
    const float** pp = (const float**)&p;
    for (int i = 0; i < 25; ++i) pp[i] = (const float*)d_in[i];
    p.out = (float*)d_out; p.ws = (unsigned char*)d_ws;
    void* args[] = {&p};
    hipError_t e = hipLaunchCooperativeKernel((const void*)fwd_megakernel, dim3(grid), dim3(512), args, LDS_BYTES, stream);
    if (e != hipSuccess) fprintf(stderr, "cooperative launch failed: %s (grid %d)\n", hipGetErrorString(e), grid);
}
```
